# Optimizing an MI355X kernel written in HIP

```python
import jax
import jax.numpy as jnp
from jax import lax
import numpy as np

D_MODEL = 2048
BATCH = 4
SEQ = 2048
DEPTH = 4
DEC_BATCH = 128
DEC_SEQ = 8
PAST_LEN = 16384
PAGE_SIZE = 128

W_GLA = 3 * D_MODEL // 8
W_LRU = 3 * D_MODEL // 8
W_RET = D_MODEL - W_GLA - W_LRU
H_GLA = 4
DV_GLA = W_GLA // H_GLA
DK_GLA = DV_GLA // 2
GLA_RANK = 16
GLA_TAU = 16.0
H_LRU = 8
BLK_LRU = W_LRU // H_LRU
LRU_CONV = 4
LRU_C = 8.0
H_RET = 4
DK_RET = W_RET // H_RET
DV_RET = W_RET // H_RET
ROPE_BASE = 10000.0
D_FF = 5632
FFN_CONV = 3
CHUNK = 64
EPS = 1e-6
IN_SIZES = (H_GLA * DK_GLA, H_GLA * DK_GLA, W_GLA, GLA_RANK, W_GLA, W_LRU, W_LRU, W_RET, W_RET, W_RET, W_RET)
N_IN = sum(IN_SIZES)

kernel_name = "hymba_gla_rglru_retention_convffn_step"


def _rmsnorm(x, g):
    xf = x.astype(jnp.float32)
    y = xf * lax.rsqrt(jnp.mean(xf * xf, axis=-1, keepdims=True) + EPS)
    return y.astype(x.dtype) * g


def _head_rmsnorm(o, g):
    y = o * lax.rsqrt(jnp.mean(o * o, axis=-1, keepdims=True) + EPS)
    B, T, H, Dv = o.shape
    return y.reshape(B, T, H * Dv) * g.astype(jnp.float32)


def _split_cols(z, sizes):
    outs = []
    off = 0
    for s in sizes:
        outs.append(z[..., off:off + s])
        off += s
    return outs


def _causal_dwconv(x, buf, w, b):
    K = w.shape[0]
    T = x.shape[1]
    xe = jnp.concatenate([buf.astype(x.dtype), x], axis=1)
    y = xe[:, 0:T] * w[0] + b
    for k in range(1, K):
        y = y + xe[:, k:k + T] * w[k]
    return y, xe[:, T:]


def _chunk_len(T):
    return CHUNK if T % CHUNK == 0 else T


def _to_chunks(a, C):
    B, T, H, X = a.shape
    return a.reshape(B, T // C, C, H, X).transpose(1, 0, 3, 2, 4)


def _from_chunks(a):
    N, B, H, C, X = a.shape
    return a.transpose(1, 0, 3, 2, 4).reshape(B, N * C, H, X)


def _rope(x, pos):
    half = x.shape[-1] // 2
    freqs = ROPE_BASE ** (-jnp.arange(half, dtype=jnp.float32) / half)
    ang = pos.astype(jnp.float32)[:, None] * freqs[None, :]
    cos = jnp.cos(ang)[None, :, None, :]
    sin = jnp.sin(ang)[None, :, None, :]
    x1 = x[..., :half].astype(jnp.float32)
    x2 = x[..., half:].astype(jnp.float32)
    return jnp.concatenate([x1 * cos - x2 * sin, x1 * sin + x2 * cos], axis=-1).astype(x.dtype)


def _gla(q, k, v, log_a, S0):
    T = q.shape[1]
    C = _chunk_len(T)
    f32 = jnp.float32
    causal = jnp.tril(jnp.ones((C, C), dtype=bool))[:, :, None]

    def step(S, inp):
        qc, kc, vc, ac = inp
        b = jnp.cumsum(ac, axis=2)
        diff = b[:, :, :, None, :] - b[:, :, None, :, :]
        decay = jnp.exp(jnp.where(causal, diff, -jnp.inf))
        att = jnp.einsum('bhtd,bhsd,bhtsd->bhts', qc, kc, decay)
        o = jnp.einsum('bhts,bhsv->bhtv', att, vc) + jnp.einsum('bhtd,bhdv->bhtv', qc * jnp.exp(b), S)
        b_last = b[:, :, -1:, :]
        S = jnp.exp(b_last[:, :, 0, :])[..., None] * S + jnp.einsum('bhsd,bhsv->bhdv', kc * jnp.exp(b_last - b), vc)
        return S, o

    xs = (_to_chunks(q.astype(f32), C), _to_chunks(k.astype(f32), C), _to_chunks(v.astype(f32), C), _to_chunks(log_a.astype(f32), C))
    S, o = lax.scan(step, S0.astype(f32), xs)
    return _from_chunks(o), S.astype(S0.dtype)


def _retention(q, k, v, S0):
    T = q.shape[1]
    H = q.shape[2]
    C = _chunk_len(T)
    f32 = jnp.float32
    log_g = jnp.log1p(-jnp.exp2(-5.0 - jnp.arange(H, dtype=f32)))
    idx = jnp.arange(C, dtype=f32)
    rel = idx[:, None] - idx[None, :]
    decay_in = jnp.where(rel[None] >= 0, jnp.exp(jnp.maximum(rel, 0.0)[None] * log_g[:, None, None]), 0.0)
    q_dec = jnp.exp((idx + 1.0)[None, :] * log_g[:, None])[None, :, :, None]
    k_dec = jnp.exp((C - 1.0 - idx)[None, :] * log_g[:, None])[None, :, :, None]
    c_dec = jnp.exp(C * log_g)[None, :, None, None]

    def step(S, inp):
        qc, kc, vc = inp
        att = jnp.einsum('bhtd,bhsd->bhts', qc, kc) * decay_in[None]
        o = jnp.einsum('bhts,bhsv->bhtv', att, vc) + jnp.einsum('bhtd,bhdv->bhtv', qc, S) * q_dec
        S = c_dec * S + jnp.einsum('bhsd,bhsv->bhdv', kc * k_dec, vc)
        return S, o

    xs = (_to_chunks(q.astype(f32), C), _to_chunks(k.astype(f32), C), _to_chunks(v.astype(f32), C))
    S, o = lax.scan(step, S0.astype(f32), xs)
    return _from_chunks(o), S.astype(S0.dtype)


def _lin_combine(left, right):
    a1, b1 = left
    a2, b2 = right
    return a1 * a2, a2 * b1 + b2


def _rglru(xc, h0, w_a, b_a, w_x, b_x, lam):
    B, T, W = xc.shape
    f32 = jnp.float32
    xf = xc.astype(f32)
    xb = xf.reshape(B, T, H_LRU, W // H_LRU)
    r = jax.nn.sigmoid(jnp.einsum('bthi,hij->bthj', xb, w_a.astype(f32)).reshape(B, T, W) + b_a.astype(f32))
    i = jax.nn.sigmoid(jnp.einsum('bthi,hij->bthj', xb, w_x.astype(f32)).reshape(B, T, W) + b_x.astype(f32))
    log_a = -LRU_C * r * jax.nn.softplus(-lam.astype(f32))
    a = jnp.exp(log_a)
    u = jnp.sqrt(-jnp.expm1(2.0 * log_a)) * (i * xf)
    u = u.at[:, 0].add(a[:, 0] * h0.astype(f32))
    _, h = lax.associative_scan(_lin_combine, (a, u), axis=1)
    return h, h[:, -1].astype(h0.dtype)


def _token_mixers(hn, pos, S_gla, S_ret, h_lru, buf_lru, w_in, gla_w_alpha, gla_b_alpha, gla_norm_g,
                  lru_conv_w, lru_conv_b, lru_w_a, lru_b_a, lru_w_x, lru_b_x, lru_lambda, ret_norm_g, w_out):
    B, T, _ = hn.shape
    f32 = jnp.float32
    z = hn @ w_in
    gq, gk, gv, g_lr, g_gate, l_x, l_gate, rq, rk, rv, r_gate = _split_cols(z, IN_SIZES)
    q = gq.reshape(B, T, H_GLA, DK_GLA) * (DK_GLA ** -0.5)
    k = gk.reshape(B, T, H_GLA, DK_GLA)
    v = gv.reshape(B, T, H_GLA, DV_GLA)
    log_a = jax.nn.log_sigmoid((g_lr @ gla_w_alpha + gla_b_alpha).astype(f32)) / GLA_TAU
    o, S_gla = _gla(q, k, v, log_a.reshape(B, T, H_GLA, DK_GLA), S_gla)
    o_gla = _head_rmsnorm(o, gla_norm_g) * jax.nn.silu(g_gate.astype(f32))
    xc, buf_lru = _causal_dwconv(l_x, buf_lru, lru_conv_w, lru_conv_b)
    h, h_lru = _rglru(xc, h_lru, lru_w_a, lru_b_a, lru_w_x, lru_b_x, lru_lambda)
    o_lru = h * jax.nn.gelu(l_gate.astype(f32))
    q = _rope(rq.reshape(B, T, H_RET, DK_RET), pos) * (DK_RET ** -0.5)
    k = _rope(rk.reshape(B, T, H_RET, DK_RET), pos)
    v = rv.reshape(B, T, H_RET, DV_RET)
    o, S_ret = _retention(q, k, v, S_ret)
    o_ret = _head_rmsnorm(o, ret_norm_g) * jax.nn.silu(r_gate.astype(f32))
    mixed = jnp.concatenate([o_gla, o_lru, o_ret], axis=-1).astype(hn.dtype)
    return mixed @ w_out, S_gla, S_ret, h_lru, buf_lru


def _conv_ffn(hn, buf, w_up, conv_w, conv_b, w_down):
    up = hn @ w_up
    u, buf = _causal_dwconv(up, buf, conv_w, conv_b)
    gate = u[..., :D_FF]
    val = u[..., D_FF:]
    return (jax.nn.silu(gate) * val) @ w_down, buf


def _run_group(x, c, start, st_gla, st_ret, st_lru, st_lru_conv, st_ffn_conv,
               norm1_g, norm2_g, final_g, w_ada, b_ada, w_in, gla_w_alpha, gla_b_alpha, gla_norm_g,
               lru_conv_w, lru_conv_b, lru_w_a, lru_b_a, lru_w_x, lru_b_x, lru_lambda, ret_norm_g, w_out,
               ffn_w_up, ffn_conv_w, ffn_conv_b, ffn_w_down):
    T = x.shape[1]
    pos = start + jnp.arange(T, dtype=jnp.int32)
    n_gla, n_ret, n_lru, n_lconv, n_fconv = [], [], [], [], []
    c_act = jax.nn.silu(c)
    for l in range(DEPTH):
        mod = c_act @ w_ada[l] + b_ada[l]
        sh1, sc1, g1, sh2, sc2, g2 = jnp.split(mod, 6, axis=-1)
        hn = _rmsnorm(x, norm1_g[l]) * (1 + sc1[:, None]) + sh1[:, None]
        m, S_gla, S_ret, h_lru, b_lru = _token_mixers(
            hn, pos, st_gla[l], st_ret[l], st_lru[l], st_lru_conv[l], w_in[l], gla_w_alpha[l], gla_b_alpha[l],
            gla_norm_g[l], lru_conv_w[l], lru_conv_b[l], lru_w_a[l], lru_b_a[l], lru_w_x[l], lru_b_x[l],
            lru_lambda[l], ret_norm_g[l], w_out[l])
        x = x + g1[:, None] * m
        hn = _rmsnorm(x, norm2_g[l]) * (1 + sc2[:, None]) + sh2[:, None]
        f, b_ffn = _conv_ffn(hn, st_ffn_conv[l], ffn_w_up[l], ffn_conv_w[l], ffn_conv_b[l], ffn_w_down[l])
        x = x + g2[:, None] * f
        n_gla.append(S_gla)
        n_ret.append(S_ret)
        n_lru.append(h_lru)
        n_lconv.append(b_lru)
        n_fconv.append(b_ffn)
    y = _rmsnorm(x, final_g)
    return y, jnp.stack(n_gla), jnp.stack(n_ret), jnp.stack(n_lru), jnp.stack(n_lconv), jnp.stack(n_fconv)


def setup_inputs(seed: int = 0) -> dict:
    key = jax.random.key(seed)
    ks = jax.random.split(key, 32)
    f32 = jnp.float32
    D = D_MODEL

    def nrm(k, shape, scale):
        return jax.random.normal(k, shape, f32) * scale

    a_c = jax.random.uniform(ks[24], (DEPTH, W_LRU), f32, 0.9, 0.999)
    a0 = a_c ** (1.0 / LRU_C)
    return {
        'x_prompt': nrm(ks[0], (BATCH, SEQ, D), 1.0),
        'x_sample': nrm(ks[1], (DEC_BATCH, DEC_SEQ, D), 1.0),
        'state_gla': nrm(ks[2], (DEPTH, DEC_BATCH, H_GLA, DK_GLA, DV_GLA), 1.0),
        'state_ret': nrm(ks[3], (DEPTH, DEC_BATCH, H_RET, DK_RET, DV_RET), 1.0),
        'state_lru': nrm(ks[4], (DEPTH, DEC_BATCH, W_LRU), 0.5),
        'state_lru_conv': nrm(ks[5], (DEPTH, DEC_BATCH, LRU_CONV - 1, W_LRU), 1.0),
        'state_ffn_conv': nrm(ks[6], (DEPTH, DEC_BATCH, FFN_CONV - 1, 2 * D_FF), 1.0),
        'c_prompt': nrm(ks[7], (BATCH, D), 1.0),
        'c_sample': nrm(ks[8], (DEC_BATCH, D), 1.0),
        'norm1_g': 1.0 + nrm(ks[9], (DEPTH, D), 0.02),
        'norm2_g': 1.0 + nrm(ks[10], (DEPTH, D), 0.02),
        'final_g': 1.0 + nrm(ks[11], (D,), 0.02),
        'w_ada': nrm(ks[12], (DEPTH, D, 6 * D), 0.5 * D ** -0.5),
        'b_ada': nrm(ks[13], (DEPTH, 6 * D), 0.02),
        'w_in': nrm(ks[14], (DEPTH, D, N_IN), D ** -0.5),
        'gla_w_alpha': nrm(ks[15], (DEPTH, GLA_RANK, H_GLA * DK_GLA), GLA_RANK ** -0.5),
        'gla_b_alpha': nrm(ks[16], (DEPTH, H_GLA * DK_GLA), 0.1),
        'gla_norm_g': 1.0 + nrm(ks[17], (DEPTH, W_GLA), 0.02),
        'lru_conv_w': nrm(ks[18], (DEPTH, LRU_CONV, W_LRU), LRU_CONV ** -0.5),
        'lru_conv_b': nrm(ks[19], (DEPTH, W_LRU), 0.02),
        'lru_w_a': nrm(ks[20], (DEPTH, H_LRU, BLK_LRU, BLK_LRU), BLK_LRU ** -0.5),
        'lru_b_a': nrm(ks[21], (DEPTH, W_LRU), 0.1),
        'lru_w_x': nrm(ks[22], (DEPTH, H_LRU, BLK_LRU, BLK_LRU), BLK_LRU ** -0.5),
        'lru_b_x': nrm(ks[23], (DEPTH, W_LRU), 0.1),
        'lru_lambda': jnp.log(a0) - jnp.log1p(-a0),
        'ret_norm_g': 1.0 + nrm(ks[25], (DEPTH, W_RET), 0.02),
        'w_out': nrm(ks[26], (DEPTH, D, D), D ** -0.5),
        'ffn_w_up': nrm(ks[27], (DEPTH, D, 2 * D_FF), D ** -0.5),
        'ffn_conv_w': nrm(ks[28], (DEPTH, FFN_CONV, 2 * D_FF), FFN_CONV ** -0.5),
        'ffn_conv_b': nrm(ks[29], (DEPTH, 2 * D_FF), 0.02),
        'ffn_w_down': nrm(ks[30], (DEPTH, D_FF, D), D_FF ** -0.5),
    }


def reference(x_prompt, x_sample, state_gla, state_ret, state_lru, state_lru_conv, state_ffn_conv,
              c_prompt, c_sample, norm1_g, norm2_g, final_g, w_ada, b_ada, w_in, gla_w_alpha, gla_b_alpha,
              gla_norm_g, lru_conv_w, lru_conv_b, lru_w_a, lru_b_a, lru_w_x, lru_b_x, lru_lambda, ret_norm_g,
              w_out, ffn_w_up, ffn_conv_w, ffn_conv_b, ffn_w_down):
    B = x_prompt.shape[0]
    dt = x_prompt.dtype
    z_gla = jnp.zeros((DEPTH, B, H_GLA, DK_GLA, DV_GLA), dt)
    z_ret = jnp.zeros((DEPTH, B, H_RET, DK_RET, DV_RET), dt)
    z_lru = jnp.zeros((DEPTH, B, W_LRU), dt)
    z_lconv = jnp.zeros((DEPTH, B, LRU_CONV - 1, W_LRU), dt)
    z_fconv = jnp.zeros((DEPTH, B, FFN_CONV - 1, 2 * D_FF), dt)
    y_prompt, p_gla, p_ret, p_lru, p_lconv, p_fconv = _run_group(
        x_prompt, c_prompt, 0, z_gla, z_ret, z_lru, z_lconv, z_fconv,
        norm1_g, norm2_g, final_g, w_ada, b_ada, w_in, gla_w_alpha, gla_b_alpha, gla_norm_g,
        lru_conv_w, lru_conv_b, lru_w_a, lru_b_a, lru_w_x, lru_b_x, lru_lambda, ret_norm_g, w_out,
        ffn_w_up, ffn_conv_w, ffn_conv_b, ffn_w_down)
    y_sample, s_gla, s_ret, s_lru, s_lconv, s_fconv = _run_group(
        x_sample, c_sample, PAST_LEN, state_gla, state_ret, state_lru, state_lru_conv, state_ffn_conv,
        norm1_g, norm2_g, final_g, w_ada, b_ada, w_in, gla_w_alpha, gla_b_alpha, gla_norm_g,
        lru_conv_w, lru_conv_b, lru_w_a, lru_b_a, lru_w_x, lru_b_x, lru_lambda, ret_norm_g, w_out,
        ffn_w_up, ffn_conv_w, ffn_conv_b, ffn_w_down)
    return (y_prompt, y_sample, p_gla, p_ret, p_lru, p_lconv, p_fconv, s_gla, s_ret, s_lru, s_lconv, s_fconv)
```

```cpp
#include <hip/hip_runtime.h>
#include <cstdio>
#include <cstdint>
#include <cmath>
namespace cfg {
constexpr int D = 2048, BATCH = 4, SEQ = 2048, DEPTH = 4, DEC_BATCH = 128, DEC_SEQ = 8, PAST = 16384;
constexpr int W_GLA = 768, W_LRU = 768, W_RET = 512;
constexpr int H_GLA = 4, DV_GLA = 192, DK_GLA = 96, GLA_RANK = 16;
constexpr int H_LRU = 8, BLK_LRU = 96;
constexpr float LRU_C = 8.0f;
constexpr int H_RET = 4, DK_RET = 128, DV_RET = 128;
constexpr int D_FF = 5632;
constexpr int N_IN = 5904;
constexpr int MP = BATCH * SEQ, MS = DEC_BATCH * DEC_SEQ, M = MP + MS, NSEQ = BATCH + DEC_BATCH;
constexpr int Z_GQ = 0, Z_GK = 384, Z_GV = 768, Z_GLR = 1536, Z_GG = 1552, Z_LX = 2320, Z_LG = 3088, Z_RQ = 3856, Z_RK = 4368, Z_RV = 4880, Z_RG = 5392;
enum { I_XP = 0, I_XS, I_SGLA, I_SRET, I_SLRU, I_SLCONV, I_SFCONV, I_CP, I_CS, I_N1G, I_N2G, I_FG, I_WADA, I_BADA, I_WIN, I_GWA, I_GBA, I_GNG, I_LCW, I_LCB, I_LWA, I_LBA, I_LWX, I_LBX, I_LLAM, I_RNG, I_WOUT, I_WUP, I_FCW, I_FCB, I_WDOWN, N_INPUTS };
constexpr size_t O_YP = 0;
constexpr size_t O_YS = O_YP + (size_t)MP * D;
constexpr size_t O_GLA_P = O_YS + (size_t)MS * D;
constexpr size_t O_RET_P = O_GLA_P + (size_t)DEPTH * BATCH * H_GLA * DK_GLA * DV_GLA;
constexpr size_t O_LRU_P = O_RET_P + (size_t)DEPTH * BATCH * H_RET * DK_RET * DV_RET;
constexpr size_t O_LCONV_P = O_LRU_P + (size_t)DEPTH * BATCH * W_LRU;
constexpr size_t O_FCONV_P = O_LCONV_P + (size_t)DEPTH * BATCH * 3 * W_LRU;
constexpr size_t O_GLA_S = O_FCONV_P + (size_t)DEPTH * BATCH * 2 * 2 * D_FF;
constexpr size_t O_RET_S = O_GLA_S + (size_t)DEPTH * DEC_BATCH * H_GLA * DK_GLA * DV_GLA;
constexpr size_t O_LRU_S = O_RET_S + (size_t)DEPTH * DEC_BATCH * H_RET * DK_RET * DV_RET;
constexpr size_t O_LCONV_S = O_LRU_S + (size_t)DEPTH * DEC_BATCH * W_LRU;
constexpr size_t O_FCONV_S = O_LCONV_S + (size_t)DEPTH * DEC_BATCH * 3 * W_LRU;
constexpr size_t O_END = O_FCONV_S + (size_t)DEPTH * DEC_BATCH * 2 * 2 * D_FF;
}
__device__ __forceinline__ int fresh_lane() { unsigned m = ~0u; asm volatile("" : "+s"(m)); return (int)__builtin_amdgcn_mbcnt_hi(m, __builtin_amdgcn_mbcnt_lo(m, 0u)); }
__device__ __forceinline__ int fresh_s(int v) { asm volatile("" : "+s"(v)); return v; }
#define FK_MULTI 0
#define HDUPMASK 0
#define HDUPUNITS 0xFF
namespace pg8 {
#define PG8_LAS __attribute__((address_space(3)))
typedef unsigned short bf16_t;
typedef short bf16x8 __attribute__((ext_vector_type(8)));
typedef float f32x4 __attribute__((ext_vector_type(4)));
typedef unsigned u32x4 __attribute__((ext_vector_type(4)));
constexpr int BM = 256, BK = 64, HALF = 128, HTB = HALF * BK * 2  , STAGE_BYTES = 8 * HTB, NXCD = 8, WGM = 12;

__host__ __device__ __forceinline__ int lds_byte(int r, int c) { const int st = (r >> 4) * 2 + (c >> 5), rr = r & 15, cc = c & 31, ob = rr * 64 + cc * 2; return st * 1024 + (ob ^ (((ob >> 9) & 1) << 5)); }
__host__ __device__ __forceinline__ void stage_rc(int b, int& R, int& C) { const int st = b / 1024, sb = b % 1024, swz = sb ^ (((sb >> 9) & 1) << 5); R = (st >> 1) * 16 + swz / 64; C = (st & 1) * 32 + (swz % 64) / 2; }
__host__ __device__ __forceinline__ int perm32(int rho) { const int n = rho >> 4, i = rho & 15; return 8 * (i >> 2) + 4 * n + (i & 3); }

struct Unit { int pm, pn, kb, nt; };
struct Gemm { const bf16_t* A; const bf16_t* Bt; int M, N, K, ldk; };

struct StaticOrder {
    int nM, nN, nwg, G, c, S, Ks, ntu, wgm;
    __host__ __device__ void init(int M, int N, int G_, int c_, int ntu_, int S_ = 1, int Ks_ = 0, int wgm_ = WGM) { nM = M / BM; nN = N / BM; nwg = nM * nN; G = G_; c = c_; ntu = ntu_; S = S_; Ks = Ks_; wgm = wgm_; }
    __host__ __device__ bool next(int i, Unit& u) const {
        const long L = (long)i * G + c; if (L >= (long)nwg * S) return false;
        int wgid = (int)(L / S); u.kb = (int)(L % S) * Ks; u.nt = ntu; { const int q = nwg / NXCD, r = nwg % NXCD, xcd = wgid % NXCD, off = wgid / NXCD; wgid = (xcd < r ? xcd * (q + 1) : r * (q + 1) + (xcd - r) * q) + off; }
        const int nig = wgm * nN, gid = wgid / nig, fm = gid * wgm, gsz = (nM - fm) < wgm ? (nM - fm) : wgm;
        u.pm = fm + ((wgid % nig) % gsz); u.pn = (wgid % nig) / gsz; return true;
    }
    __device__ __forceinline__ void a_ready(const Unit&) const {}
    __device__ __forceinline__ void done(const Unit&) const {}
};

__device__ __forceinline__ unsigned cvt_pk_bf16(float lo, float hi) { unsigned r; asm volatile("v_cvt_pk_bf16_f32 %0, %1, %2" : "=v"(r) : "v"(lo), "v"(hi)); return r; }
typedef float f32x2 __attribute__((ext_vector_type(2)));
template <class Epi, class Sched, bool ALIGN_EPI = false, bool SP2 = false>
__device__ __forceinline__ void gemm_phase(PG8_LAS unsigned char* lds, const Gemm g, const Sched& S, const Epi& E, const int wave_id) {
    const int lane = fresh_lane(), wid = fresh_s(wave_id), tid = wid * 64 + lane, wr = wid >> 2, wc = wid & 3, fr = lane & 15, fq = lane >> 4;
    const int K = g.ldk;
    unsigned voffA[2], voffB[2];
#pragma unroll
    for (int i = 0; i < 2; ++i) { int R, C; stage_rc(tid * 16 + i * 8192, R, C); const int Rb = Epi::PERM ? ((R & ~31) + perm32(R & 31)) : R;
        voffA[i] = (unsigned)(R * K + C) * 2u; voffB[i] = (unsigned)(Rb * K + C) * 2u; }
    const size_t kstep = (size_t)(BK * 2);
    const size_t hstep = (size_t)HALF * K * 2;
    const size_t tstep = 2 * hstep;
    const unsigned ldsw = (unsigned)wid * 1024u;
    const int aoff = lds_byte(wr * 64 + fr, fq * 8), boff = lds_byte(wc * 32 + fr, fq * 8);
#define PG8_SA(b, h) (((b) * 2 + (h)) * HTB)
#define PG8_SB(b, h) ((4 + (b) * 2 + (h)) * HTB)
#define PG8_STAGE(bufoff, gbase, voff) do { _Pragma("unroll") for (int _i = 0; _i < 2; ++_i) \
        __builtin_amdgcn_global_load_lds((const unsigned*)((const char*)(gbase) + (voff)[_i]), (PG8_LAS unsigned*)(lds + (bufoff) + ldsw + _i * 8192), 16, 0, 0); } while (0)
#define PG8_LDA(dst, b, h) do { _Pragma("unroll") for (int m = 0; m < 4; ++m) _Pragma("unroll") for (int k = 0; k < 2; ++k) dst[m][k] = *(const PG8_LAS bf16x8*)(lds + PG8_SA(b, h) + aoff + m * 2048 + k * 1024); } while (0)
#define PG8_LDB(dst, b, h) do { _Pragma("unroll") for (int n = 0; n < 2; ++n) _Pragma("unroll") for (int k = 0; k < 2; ++k) dst[n][k] = *(const PG8_LAS bf16x8*)(lds + PG8_SB(b, h) + boff + n * 2048 + k * 1024); } while (0)
#define PG8_MMA(ai, bj, At, Bt) do { __builtin_amdgcn_s_setprio(1); _Pragma("unroll") for (int m = 0; m < 4; ++m) _Pragma("unroll") for (int n = 0; n < 2; ++n) _Pragma("unroll") for (int k = 0; k < 2; ++k) \
        acc[ai][bj][m][n] = __builtin_amdgcn_mfma_f32_16x16x32_bf16(Bt[n][k], At[m][k], acc[ai][bj][m][n], 0, 0, 0); __builtin_amdgcn_s_setprio(0); } while (0)
#define PG8_WAIT_V(n) asm volatile("s_waitcnt vmcnt(" #n ")" ::: "memory")
#define PG8_WAIT_L(n) asm volatile("s_waitcnt lgkmcnt(" #n ")" ::: "memory")
#define PG8_BAR __builtin_amdgcn_s_barrier()
#define PG8_SCHED __builtin_amdgcn_sched_barrier(0)
    Unit cur, nxt; int ui = 0;
    if (!S.next(0, cur)) return;
    f32x4 acc[2][2][4][2];
#pragma unroll
    for (int a = 0; a < 2; ++a)
#pragma unroll
        for (int b = 0; b < 2; ++b)
#pragma unroll
            for (int m = 0; m < 4; ++m)
#pragma unroll
                for (int n = 0; n < 2; ++n) acc[a][b][m][n] = (f32x4){0.f, 0.f, 0.f, 0.f};
    bf16x8 At[4][2], B0[2][2], B1[2][2];
    const char* cA = (const char*)g.A + (size_t)cur.pm * tstep + (size_t)cur.kb * 2; const char* cB = (const char*)g.Bt + (size_t)cur.pn * tstep + (size_t)cur.kb * 2;
    S.a_ready(cur);
    if constexpr (SP2) {
        PG8_STAGE(PG8_SB(0, 0), cB, voffB); PG8_STAGE(PG8_SB(0, 1), cB + hstep, voffB); PG8_STAGE(PG8_SA(0, 0), cA, voffA); PG8_STAGE(PG8_SA(0, 1), cA + hstep, voffA);
        if (wr == 1) PG8_BAR;
        PG8_WAIT_V(2); PG8_BAR;
        PG8_STAGE(PG8_SB(1, 0), cB + kstep, voffB); PG8_STAGE(PG8_SA(1, 0), cA + kstep, voffA); PG8_STAGE(PG8_SB(1, 1), cB + hstep + kstep, voffB);
        PG8_WAIT_V(6); PG8_BAR;
    } else {
        PG8_STAGE(PG8_SB(0, 0), cB, voffB); PG8_STAGE(PG8_SA(0, 0), cA, voffA); PG8_STAGE(PG8_SB(0, 1), cB + hstep, voffB); PG8_STAGE(PG8_SA(0, 1), cA + hstep, voffA);
        if (wr == 1) PG8_BAR;
        PG8_WAIT_V(4); PG8_BAR;
        PG8_STAGE(PG8_SB(1, 0), cB + kstep, voffB); PG8_STAGE(PG8_SA(1, 0), cA + kstep, voffA); PG8_STAGE(PG8_SB(1, 1), cB + hstep + kstep, voffB);
        PG8_WAIT_V(6); PG8_BAR;
    }
    for (;;) {
        const bool has_next = S.next(ui + 1, nxt);
        const char* nA = has_next ? (const char*)g.A + (size_t)nxt.pm * tstep + (size_t)nxt.kb * 2 : cA; const char* nB = has_next ? (const char*)g.Bt + (size_t)nxt.pn * tstep + (size_t)nxt.kb * 2 : cB;
        const int nt = cur.nt;
        for (int t = 0; t < nt; t += 2) {
            const bool last = (t == nt - 2);
            const char* a1 = cA + (size_t)(t + 1) * kstep;
            const char* a2 = last ? nA : cA + (size_t)(t + 2) * kstep; const char* b2 = last ? nB : cB + (size_t)(t + 2) * kstep;
            const char* a3 = a2 + kstep; const char* b3 = b2 + kstep;
            if (last && has_next) S.a_ready(nxt);
            if constexpr (SP2) {
            PG8_LDB(B0, 0, 0); PG8_LDB(B1, 0, 1); PG8_SCHED; PG8_LDA(At, 0, 0); PG8_STAGE(PG8_SA(1, 1), a1 + hstep, voffA);
            PG8_WAIT_V(8); PG8_WAIT_L(0); PG8_BAR; PG8_MMA(0, 0, At, B0); PG8_MMA(0, 1, At, B1); PG8_BAR; PG8_SCHED;
            PG8_LDA(At, 0, 1); PG8_STAGE(PG8_SB(0, 0), b2, voffB); PG8_STAGE(PG8_SB(0, 1), b2 + hstep, voffB); PG8_STAGE(PG8_SA(0, 0), a2, voffA);
            PG8_WAIT_V(8); PG8_WAIT_L(0); PG8_BAR; PG8_MMA(1, 0, At, B0); PG8_MMA(1, 1, At, B1); PG8_BAR; PG8_SCHED;
            PG8_LDB(B0, 1, 0); PG8_LDB(B1, 1, 1); PG8_SCHED; PG8_LDA(At, 1, 0); PG8_STAGE(PG8_SA(0, 1), a2 + hstep, voffA);
            PG8_WAIT_V(8); PG8_WAIT_L(0); PG8_BAR; PG8_MMA(0, 0, At, B0); PG8_MMA(0, 1, At, B1); PG8_BAR; PG8_SCHED;
            PG8_LDA(At, 1, 1); PG8_STAGE(PG8_SB(1, 0), b3, voffB); PG8_STAGE(PG8_SB(1, 1), b3 + hstep, voffB); PG8_STAGE(PG8_SA(1, 0), a3, voffA);
            PG8_WAIT_V(8); PG8_WAIT_L(0); PG8_BAR; PG8_MMA(1, 0, At, B0); PG8_MMA(1, 1, At, B1); PG8_BAR; PG8_SCHED;
            } else {
            PG8_LDB(B0, 0, 0); PG8_SCHED; PG8_LDA(At, 0, 0); PG8_STAGE(PG8_SA(1, 1), a1 + hstep, voffA);
            PG8_WAIT_L(8); PG8_BAR; PG8_WAIT_L(0); PG8_MMA(0, 0, At, B0); PG8_BAR; PG8_SCHED;
            PG8_LDB(B1, 0, 1); PG8_STAGE(PG8_SB(0, 0), b2, voffB);
            PG8_BAR; PG8_WAIT_L(0); PG8_MMA(0, 1, At, B1); PG8_BAR;
            PG8_LDA(At, 0, 1); PG8_STAGE(PG8_SA(0, 0), a2, voffA);
            PG8_BAR; PG8_WAIT_L(0); PG8_MMA(1, 0, At, B0); PG8_BAR; PG8_SCHED;
            PG8_STAGE(PG8_SB(0, 1), b2 + hstep, voffB);
            PG8_WAIT_V(6); PG8_BAR; PG8_MMA(1, 1, At, B1); PG8_BAR;
            PG8_LDB(B0, 1, 0); PG8_SCHED; PG8_LDA(At, 1, 0); PG8_STAGE(PG8_SA(0, 1), a2 + hstep, voffA);
            PG8_WAIT_L(8); PG8_BAR; PG8_WAIT_L(0); PG8_MMA(0, 0, At, B0); PG8_BAR; PG8_SCHED;
            PG8_LDB(B1, 1, 1); PG8_STAGE(PG8_SB(1, 0), b3, voffB);
            PG8_BAR; PG8_WAIT_L(0); PG8_MMA(0, 1, At, B1); PG8_BAR;
            PG8_LDA(At, 1, 1); PG8_STAGE(PG8_SA(1, 0), a3, voffA);
            PG8_BAR; PG8_WAIT_L(0); PG8_MMA(1, 0, At, B0); PG8_BAR; PG8_SCHED;
            PG8_STAGE(PG8_SB(1, 1), b3 + hstep, voffB);
            PG8_WAIT_V(6); PG8_BAR; PG8_MMA(1, 1, At, B1); PG8_BAR;
            }
        }
        if constexpr (ALIGN_EPI) { if (wr == 0) PG8_BAR; }
        if constexpr (!Epi::AFTER_DRAIN) { E(acc, cur, wr, wc, fr, fq); S.done(cur); }
        if (!has_next) break;
#pragma unroll
        for (int a = 0; a < 2; ++a)
#pragma unroll
            for (int b = 0; b < 2; ++b)
#pragma unroll
                for (int m = 0; m < 4; ++m)
#pragma unroll
                    for (int n = 0; n < 2; ++n) acc[a][b][m][n] = (f32x4){0.f, 0.f, 0.f, 0.f};
        cur = nxt; cA = nA; cB = nB; ++ui;
        if constexpr (ALIGN_EPI) { if (wr == 1) PG8_BAR; }
    }
    PG8_WAIT_V(0);
    if constexpr (!ALIGN_EPI) { if (wr == 0) PG8_BAR; }
    PG8_BAR;
    if constexpr (Epi::AFTER_DRAIN) { E.fused(acc, cur, wr, wc, fr, fq, lds, wid, lane); S.done(cur); }
#undef PG8_SA
#undef PG8_SB
#undef PG8_STAGE
#undef PG8_LDA
#undef PG8_LDB
#undef PG8_MMA
#undef PG8_WAIT_V
#undef PG8_WAIT_L
#undef PG8_BAR
#undef PG8_SCHED
}
}
namespace fk {
using namespace cfg;
using pg8::bf16_t; using pg8::bf16x8; using pg8::f32x4; using pg8::u32x4;
#define LAS __attribute__((address_space(3)))
#define GAS __attribute__((address_space(1)))
typedef unsigned u32x2 __attribute__((ext_vector_type(2)));
typedef float f32x2 __attribute__((ext_vector_type(2)));
typedef short s16x4 __attribute__((ext_vector_type(4)));
constexpr int NWAVES = 8, NTHR = 512;
#ifndef ADA_DIRECT
#define ADA_DIRECT 1
#endif
constexpr int SPLIT = 4;
constexpr int ZLD = 6144;
constexpr int F_GQ = 0, F_GK = 384, F_GV = 768, F_GG = 1536, F_LX = 2304, F_LG = 3072, F_RQ = 3840, F_RK = 4352, F_RV = 4864, F_RG = 5376, F_GLR = 5888;
constexpr int NCH = SEQ / 64;
constexpr int MODLD = DEPTH * 6 * D;
constexpr int NPOS = SEQ + DEC_SEQ;
constexpr size_t al(size_t x) { return (x + 4095) / 4096 * 4096; }
constexpr size_t WS_CTL = 0, CTL_ZERO_BYTES = 1u << 20;
constexpr size_t WS_WIN = al(WS_CTL + CTL_ZERO_BYTES);
constexpr size_t WS_WOUT = al(WS_WIN + (size_t)DEPTH * ZLD * D * 2);
constexpr size_t WS_WUP = al(WS_WOUT + (size_t)DEPTH * D * D * 2);
constexpr size_t WS_WDOWN = al(WS_WUP + (size_t)DEPTH * 2 * D_FF * D * 2);
constexpr size_t WS_WADA = al(WS_WDOWN + (size_t)DEPTH * D * D_FF * 2);
constexpr size_t WS_LRUW = al(WS_WADA + (size_t)MODLD * D * 2);
constexpr size_t WS_CACT = al(WS_LRUW + (size_t)DEPTH * 2 * 8 * 96 * 96 * 2);
constexpr size_t WS_MOD = al(WS_CACT + (size_t)256 * D * 2);
constexpr size_t WS_ROPE = al(WS_MOD + (size_t)256 * MODLD * 4);
constexpr size_t WS_X = al(WS_ROPE + (size_t)NPOS * 64 * 8);
constexpr size_t WS_HN = al(WS_X + (size_t)M * D * 4);
constexpr size_t WS_Z = al(WS_HN + (size_t)M * D * 2);
constexpr size_t WS_MIX = al(WS_Z + (size_t)M * ZLD * 2);
constexpr size_t WS_H = al(WS_MIX + (size_t)M * D * 2);
constexpr size_t WS_RAW = al(WS_H + (size_t)M * D_FF * 2);
constexpr size_t WS_DSG = al(WS_RAW + (size_t)(M / 256) * 4 * 2 * D_FF * 4);
constexpr size_t WS_DSR = al(WS_DSG + (size_t)BATCH * NCH * 4 * DV_GLA * DK_GLA * 4);
constexpr size_t WS_SSG = al(WS_DSR + (size_t)BATCH * NCH * 4 * DV_RET * DK_RET * 4);
constexpr size_t WS_SSR = al(WS_SSG + (size_t)BATCH * NCH * 4 * DV_GLA * DK_GLA * 2);
constexpr size_t WS_DECG = al(WS_SSR + (size_t)BATCH * NCH * 4 * DV_RET * DK_RET * 2);
constexpr size_t WS_LAB = al(WS_DECG + (size_t)BATCH * NCH * 4 * DK_GLA * 4);
constexpr size_t WS_LHS = al(WS_LAB + (size_t)BATCH * NCH * W_LRU * 2 * 4);
constexpr size_t WS_SPL = al(WS_LHS + (size_t)BATCH * NCH * W_LRU * 4);
constexpr size_t WS_PART = al(WS_SPL + (size_t)DEPTH * W_LRU * 4);
constexpr size_t WS_RAWS = al(WS_PART + (size_t)3 * MS * D * 4);
constexpr size_t WS_LAG = al(WS_RAWS + (size_t)DEC_BATCH * 2 * 2 * D_FF * 4);
constexpr size_t WS_LUG = al(WS_LAG + (size_t)MP * W_LRU * 4);
constexpr size_t WS_END = al(WS_LUG + (size_t)MP * W_LRU * 4);
constexpr int CW_BAR = 4096;
constexpr int RING_BYTES = 131072;
constexpr int HALO_OFF = RING_BYTES;
constexpr int LDS_BYTES = 163840;
constexpr int MISC_OFF = LDS_BYTES - 256;
static_assert(HALO_OFF + 8192 <= MISC_OFF, "LDS map");

#define LDS_WAIT() asm volatile("s_waitcnt lgkmcnt(0)" ::: "memory")
#define VM_WAIT() asm volatile("s_waitcnt vmcnt(0)" ::: "memory")
__device__ __forceinline__ unsigned cvt_pk(float lo, float hi) { unsigned r; asm volatile("v_cvt_pk_bf16_f32 %0, %1, %2" : "=v"(r) : "v"(lo), "v"(hi)); return r; }
__device__ __forceinline__ unsigned short f2bf(float f) { return (unsigned short)(cvt_pk(f, 0.f) & 0xffffu); }
__device__ __forceinline__ float bf2f(unsigned short h) { return __builtin_bit_cast(float, (unsigned)h << 16); }
__device__ __forceinline__ float bflo(unsigned u) { return __builtin_bit_cast(float, u << 16); }
__device__ __forceinline__ float bfhi(unsigned u) { return __builtin_bit_cast(float, u & 0xffff0000u); }
__device__ __forceinline__ float fexp(float x) { return __expf(x); }
__device__ __forceinline__ float sigm(float x) { return __builtin_amdgcn_rcpf(1.f + __expf(-x)); }
__device__ __forceinline__ float siluf(float x) { return x * __builtin_amdgcn_rcpf(1.f + __expf(-x)); }
__device__ __forceinline__ float logsig(float x) { return fminf(x, 0.f) - __logf(1.f + __expf(-fabsf(x))); }
__device__ __forceinline__ float gelu_t(float x) { const float u = 0.7978845608028654f * (x + 0.044715f * x * x * x); return x * (1.f - __builtin_amdgcn_rcpf(1.f + __expf(2.f * u))); }
__device__ __forceinline__ int row_seq(int row) { return row < MP ? row / SEQ : BATCH + ((row - MP) >> 3); }
__device__ __forceinline__ float wave_sum(float v) {
#pragma unroll
    for (int o = 1; o < 64; o <<= 1) v += __shfl_xor(v, o);
    return v;
}

#define XB_TMO      128
#define XB_XCNT(j)  (256  + 64 * (j))
#define XB_XSUB(j)  (1280 + 64 * (j))
#define XB_XGEN(j)  (2304 + 64 * (j))
#define XB_TOP      3328
#define XB_TOPGEN   3392
#define XCD_BAR_WORDS 3456
#define XB_SPIN_CAP (1u << 18)
__device__ __forceinline__ unsigned xb_ld(unsigned* p)              { return __hip_atomic_load(p, __ATOMIC_RELAXED, __HIP_MEMORY_SCOPE_AGENT); }
__device__ __forceinline__ unsigned xb_add(unsigned* p, unsigned v) { return __hip_atomic_fetch_add(p, v, __ATOMIC_RELAXED, __HIP_MEMORY_SCOPE_AGENT); }
__device__ __forceinline__ unsigned xb_xcc_id() { return (unsigned)__builtin_amdgcn_s_getreg((3 << 11) | 20) & 0xFu; }
#define XB_SPIN(cond, bar) do { unsigned _sp = 0; while (cond) { __builtin_amdgcn_s_sleep(1); \
    if ((++_sp & 255u) == 0u) { if (xb_ld(&(bar)[XB_TMO])) break; if (_sp > XB_SPIN_CAP) { atomicAdd(&(bar)[XB_TMO], 1u); break; } } } } while (0)
struct XcdBarrier { unsigned* bar; unsigned x; volatile LAS unsigned* st; };
__device__ __forceinline__ XcdBarrier xcd_barrier_post(unsigned* bar, volatile LAS unsigned* st, bool tid0) {
    XcdBarrier b; b.bar = bar; b.x = xb_xcc_id(); b.st = st;
    if (tid0) (void)xb_add(&bar[XB_XCNT(b.x)], 1u);
    return b;
}
__device__ __forceinline__ void xcd_barrier_complete(unsigned* bar, unsigned x, unsigned& nloc, unsigned& nx) {
    const unsigned G = gridDim.x * gridDim.y * gridDim.z;
    unsigned sum, cnt, mine, sp = 0u;
    for (;;) {
        sum = 0u; cnt = 0u; mine = 0u;
#pragma unroll
        for (unsigned j = 0; j < 16; ++j) { const unsigned c = xb_ld(&bar[XB_XCNT(j)]); sum += c; cnt += (c > 0u) ? 1u : 0u; mine = (j == x) ? c : mine; }
        if (sum == G) break;
        __builtin_amdgcn_s_sleep(1);
        if ((++sp & 255u) == 0u) { if (xb_ld(&bar[XB_TMO])) break; if (sp > XB_SPIN_CAP) { atomicAdd(&bar[XB_TMO], 1u); break; } }
    }
    nloc = mine > 0u ? mine : 1u; nx = cnt > 0u ? cnt : 1u;
}
__device__ __forceinline__ void xcd_barrier(const XcdBarrier& b, bool tid0) {
    asm volatile("s_waitcnt vmcnt(0)" ::: "memory");
    __syncthreads();
    if (tid0) {
        unsigned* bar = b.bar; unsigned bx = b.x; asm volatile("" : "+s"(bar), "+s"(bx));
        __builtin_amdgcn_s_waitcnt(0);
        unsigned nloc = b.st[0], nx = b.st[1];
        if (nloc == 0u) { xcd_barrier_complete(bar, bx, nloc, nx); b.st[0] = nloc; b.st[1] = nx; }
        const unsigned old = xb_add(&bar[XB_XSUB(bx)], 1u);
        const unsigned gen = old / nloc;
        if (old + 1u == (gen + 1u) * nloc) {
            __builtin_amdgcn_fence(__ATOMIC_RELEASE, "agent");
            asm volatile("s_waitcnt vmcnt(0)" ::: "memory");
            const unsigned og = xb_add(&bar[XB_TOP], 1u);
            const unsigned tg = og / nx;
            if (og + 1u == (tg + 1u) * nx) xb_add(&bar[XB_TOPGEN], 1u);
            else XB_SPIN(xb_ld(&bar[XB_TOPGEN]) == tg, bar);
            __builtin_amdgcn_fence(__ATOMIC_ACQUIRE, "agent");
            xb_add(&bar[XB_XGEN(bx)], 1u);
            asm volatile("s_waitcnt vmcnt(0)" ::: "memory");
        } else {
            XB_SPIN(xb_ld(&bar[XB_XGEN(bx)]) == gen, bar);
            __builtin_amdgcn_fence(__ATOMIC_ACQUIRE, "agent");
            asm volatile("s_waitcnt vmcnt(0)" ::: "memory");
        }
    }
    __syncthreads();
}

#define INP(i) finp(F.inp, (i))
__device__ __forceinline__ const float* finp(const float* const* tab, int i) { asm volatile("" : "+s"(i)); return (const float*)(const GAS float*)tab[i]; }
__device__ __forceinline__ size_t fwo(unsigned o) { asm volatile("" : "+s"(o)); return (size_t)o << 8; }
struct Frame {
    LAS unsigned char* lds; volatile LAS unsigned* MISC;
    int wave, G, gw, NGW, umask;
    const float* const* inp; float* out; unsigned char* ws;
};

__device__ __forceinline__ void transpose_item(const float* W, int ldn, int src_col, int nvalid, bf16_t* WT, int Kd, int dst_row, int k0, LAS float* scr, int lane) {
    const bool ok = lane < nvalid; const float* p = W + (size_t)k0 * ldn + src_col + lane;
#pragma unroll
    for (int h = 0; h < 2; ++h) { float v[32];
#pragma unroll
        for (int i = 0; i < 32; ++i) v[i] = ok ? __builtin_nontemporal_load(p + (size_t)(32 * h + i) * ldn) : 0.f;
#pragma unroll
        for (int i = 0; i < 32; ++i) scr[(32 * h + i) * 65 + lane] = v[i]; }
    LDS_WAIT(); asm volatile("" ::: "memory");
    const int c = lane & 7;
#pragma unroll
    for (int j = 0; j < 8; ++j) { const int n = (lane >> 3) + 8 * j; const LAS float* s = scr + (8 * c) * 65 + n;
        u32x4 o; o.x = cvt_pk(s[0 * 65], s[1 * 65]); o.y = cvt_pk(s[2 * 65], s[3 * 65]); o.z = cvt_pk(s[4 * 65], s[5 * 65]); o.w = cvt_pk(s[6 * 65], s[7 * 65]);
        __builtin_nontemporal_store(o, (GAS u32x4*)(WT + (size_t)(dst_row + n) * Kd + k0 + 8 * c)); }
    LDS_WAIT(); asm volatile("" ::: "memory");
}
constexpr int I_IN = (D / 64) * (ZLD / 64), I_OUT = (D / 64) * (D / 64), I_UP = (D / 64) * (2 * D_FF / 64), I_DN = (D_FF / 64) * (D / 64), I_AD = (D / 64) * (6 * D / 64);
constexpr int PER_L4 = I_IN + I_OUT + I_UP + I_DN;
__device__ __forceinline__ void layer_item(Frame& F, int l, int r, LAS float* scr, int lane) {
    if (r < I_IN) { const int nblk = ZLD / 64, kb = r / nblk, n0 = 64 * (r % nblk); int src, nv;
        if (n0 < 1536) { src = n0; nv = 64; } else if (n0 < F_GLR) { src = n0 + 16; nv = 64; } else if (n0 == F_GLR) { src = Z_GLR; nv = 16; } else { src = 0; nv = 0; }
        transpose_item(INP(I_WIN) + (size_t)l * D * N_IN, N_IN, src, nv, ((bf16_t*)(F.ws + fwo((unsigned)(WS_WIN >> 8)))) + (size_t)l * ZLD * D, D, n0, 64 * kb, scr, lane); return; } r -= I_IN;
    if (r < I_OUT) { const int nblk = D / 64, kb = r / nblk, n0 = 64 * (r % nblk);
        transpose_item(INP(I_WOUT) + (size_t)l * D * D, D, n0, 64, ((bf16_t*)(F.ws + fwo((unsigned)(WS_WOUT >> 8)))) + (size_t)l * D * D, D, n0, 64 * kb, scr, lane); return; } r -= I_OUT;
    if (r < I_UP) { const int nblk = 2 * D_FF / 64, kb = r / nblk, n0 = 64 * (r % nblk), pn = n0 >> 8, c0 = n0 & 255; const int src = c0 < 128 ? 128 * pn + c0 : D_FF + 128 * pn + (c0 - 128);
        transpose_item(INP(I_WUP) + (size_t)l * D * 2 * D_FF, 2 * D_FF, src, 64, ((bf16_t*)(F.ws + fwo((unsigned)(WS_WUP >> 8)))) + (size_t)l * 2 * D_FF * D, D, n0, 64 * kb, scr, lane); return; } r -= I_UP;
    { const int nblk = D / 64, kb = r / nblk, n0 = 64 * (r % nblk);
        transpose_item(INP(I_WDOWN) + (size_t)l * D_FF * D, D, n0, 64, ((bf16_t*)(F.ws + fwo((unsigned)(WS_WDOWN >> 8)))) + (size_t)l * D * D_FF, D_FF, n0, 64 * kb, scr, lane); }
}
constexpr int CW_QUEUE = 8192, Q_CHUNK = 4, Q_TOTAL = DEPTH * PER_L4, Q_PRE = I_IN + I_OUT + (PER_L4 * 10) / 100;
__device__ __forceinline__ void steal_transposes(Frame& F, int cap) {
    if (cap > Q_TOTAL) cap = Q_TOTAL;
    const int lane = fresh_lane(), wave = fresh_s(F.wave); LAS float* scr = (LAS float*)(F.lds + wave * 16896);
    unsigned* ctr = (unsigned*)(F.ws + WS_CTL) + CW_QUEUE;
    for (;;) {
        if (Q_PRE + (int)__builtin_amdgcn_readfirstlane((int)__hip_atomic_load(ctr, __ATOMIC_RELAXED, __HIP_MEMORY_SCOPE_AGENT)) >= cap) break;
        unsigned base = 0u; if (lane == 0) base = __hip_atomic_fetch_add(ctr, (unsigned)Q_CHUNK, __ATOMIC_RELAXED, __HIP_MEMORY_SCOPE_AGENT);
        const int b0 = Q_PRE + __builtin_amdgcn_readfirstlane((int)base); if (b0 >= Q_TOTAL) break;
        for (int k = 0; k < Q_CHUNK && b0 + k < Q_TOTAL; ++k) { const int g = b0 + k; layer_item(F, g / PER_L4, g % PER_L4, scr, lane); }
    }
}
__device__ __forceinline__ int qcap(int l, int soft_pct, int need) { const int soft = l * PER_L4 + Q_PRE + (PER_L4 * soft_pct) / 100, must = l * PER_L4 + need; return soft > must ? soft : must; }
__device__ __forceinline__ void p0_prologue(Frame& F) {
    const int plane = fresh_lane(), pwave = fresh_s(F.wave), ptid = pwave * 64 + plane;
    LAS float* scr = (LAS float*)(F.lds + pwave * 16896);
    constexpr int NITEMS = (ADA_DIRECT ? Q_PRE : PER_L4 + DEPTH * I_AD);
    for (int it = fresh_s(F.gw); it < NITEMS; it += F.NGW) {
        if (it < (ADA_DIRECT ? Q_PRE : PER_L4)) { layer_item(F, 0, it, scr, plane); continue; }
        const int q = it - PER_L4, l = q / I_AD, r = q % I_AD; const int nblk = 6 * D / 64, kb = r / nblk, n0 = 64 * (r % nblk);
        transpose_item(INP(I_WADA) + (size_t)l * D * 6 * D, 6 * D, n0, 64, ((bf16_t*)(F.ws + fwo((unsigned)(WS_WADA >> 8)))) + (size_t)l * 6 * D * D, D, n0, 64 * kb, scr, plane);
    }
    const int gt = (int)blockIdx.x * NTHR + ptid, NGT = F.G * NTHR;
    const float* cpp = INP(I_CP); const float* csp = INP(I_CS);
    for (int i = gt; i < 256 * D / 2; i += NGT) { const int s = (2 * i) / D, k = (2 * i) % D; float a = 0.f, b = 0.f;
        if (s < NSEQ) { const float* c = s < BATCH ? cpp + (size_t)s * D : csp + (size_t)(s - BATCH) * D; a = siluf(c[k]); b = siluf(c[k + 1]); }
        ((unsigned*)((bf16_t*)(F.ws + fwo((unsigned)(WS_CACT >> 8)))))[i] = cvt_pk(a, b); }
    for (int i = gt; i < NPOS * 64; i += NGT) { const int p = i >> 6, j = i & 63; const int pos = p < SEQ ? p : PAST + (p - SEQ);
        const float fr = powf(10000.f, -(float)j / 64.f); const float ang = (float)pos * fr; float sn, cs; sincosf(ang, &sn, &cs); ((f32x2*)((float*)(F.ws + fwo((unsigned)(WS_ROPE >> 8)))))[i] = (f32x2){cs, sn}; }
    const float* lwa = INP(I_LWA); const float* lwx = INP(I_LWX);
    { constexpr int NTOT = DEPTH * 2 * 8 * 96 * 96; bf16_t* LW = ((bf16_t*)(F.ws + fwo((unsigned)(WS_LRUW >> 8))));
      for (int i0 = gt; i0 < NTOT; i0 += 5 * NGT) { float wv[5];
#pragma unroll
          for (int k = 0; k < 5; ++k) { const int i = i0 + k * NGT; wv[k] = 0.f;
              if (i < NTOT) { const int ii = i % 96, jo = (i / 96) % 96, g = (i / 9216) % 8, mat = (i / 73728) % 2, l = i / 147456; const float* W = mat ? lwx : lwa; wv[k] = W[(((size_t)l * 8 + g) * 96 + ii) * 96 + jo]; } }
#pragma unroll
          for (int k = 0; k < 5; ++k) { const int i = i0 + k * NGT; if (i < NTOT) LW[i] = f2bf(wv[k]); } } }
    { const float* lam = INP(I_LLAM); float* spl = ((float*)(F.ws + fwo((unsigned)(WS_SPL >> 8))));
      for (int i = gt; i < DEPTH * W_LRU; i += NGT) { const float x = -lam[i]; spl[i] = fmaxf(x, 0.f) + log1pf(expf(-fabsf(x))); } }
}

__device__ __forceinline__ void add_parts(Frame& F, int m, int lane, f32x4 (&v)[8]) {
    const float* P = ((float*)(F.ws + fwo((unsigned)(WS_PART >> 8)))) + (size_t)(m - MP) * D + 4 * lane; float* xw = ((float*)(F.ws + fwo((unsigned)(WS_X >> 8)))) + (size_t)m * D + 4 * lane;
#pragma unroll
    for (int j = 0; j < 8; ++j) { f32x4 a = v[j];
#pragma unroll
        for (int s = 0; s < SPLIT - 1; ++s) a += *(const f32x4*)(P + (size_t)s * MS * D + 256 * j);
        v[j] = a; *(f32x4*)(xw + 256 * j) = a; }
}
__device__ __forceinline__ void norm_phase(Frame& F, const float* g, int modoff_sh, int modoff_sc, bool has_part, const float* xp, const float* xs) {
    const int lane = fresh_lane(); const int m0 = fresh_s(F.gw);
    float* X = ((float*)(F.ws + fwo((unsigned)(WS_X >> 8)))); const float* MODp = ((float*)(F.ws + fwo((unsigned)(WS_MOD >> 8)))); bf16_t* HN = ((bf16_t*)(F.ws + fwo((unsigned)(WS_HN >> 8))));
    f32x4 gg[8], v[8];
#pragma unroll
    for (int j = 0; j < 8; ++j) gg[j] = *(const f32x4*)(g + 4 * lane + 256 * j);
    auto xrow = [&](int m) { return (const GAS f32x4*)(xp ? (m < MP ? xp + (size_t)m * D : xs + (size_t)(m - MP) * D) : X + (size_t)m * D) + lane; };
    if (m0 < M) { const GAS f32x4* xr = xrow(m0);
#pragma unroll
        for (int j = 0; j < 8; ++j) v[j] = xr[64 * j]; }
#pragma unroll 1
    for (int m = m0; m < M; m += F.NGW) {
        const float* mrow = MODp + (size_t)row_seq(m) * MODLD; f32x4 sc[8], sh[8], nx[8];
#pragma unroll
        for (int j = 0; j < 8; ++j) { sc[j] = *(const f32x4*)(mrow + modoff_sc + 4 * lane + 256 * j); sh[j] = *(const f32x4*)(mrow + modoff_sh + 4 * lane + 256 * j); }
        const int mn = m + F.NGW;
        if (mn < M) { const GAS f32x4* xr = xrow(mn);
#pragma unroll
            for (int j = 0; j < 8; ++j) nx[j] = xr[64 * j]; }
        if (has_part && m >= MP) add_parts(F, m, lane, v);
        float s = 0.f;
#pragma unroll
        for (int j = 0; j < 8; ++j) s += (v[j].x * v[j].x + v[j].y * v[j].y) + (v[j].z * v[j].z + v[j].w * v[j].w);
        const float rstd = rsqrtf(wave_sum(s) * (1.f / D) + 1e-6f);
        GAS u32x2* o8 = (GAS u32x2*)(HN + (size_t)m * D) + lane;
#pragma unroll
        for (int j = 0; j < 8; ++j) { const f32x4 y = (v[j] * rstd * gg[j]) * (sc[j] + 1.f) + sh[j]; o8[64 * j] = (u32x2){cvt_pk(y.x, y.y), cvt_pk(y.z, y.w)}; }
#pragma unroll
        for (int j = 0; j < 8; ++j) v[j] = nx[j];
    }
}
__device__ __forceinline__ void final_norm_phase(Frame& F) {
    const float* g = INP(I_FG);
    const int lane = fresh_lane(); const int m0 = fresh_s(F.gw);
    float* X = ((float*)(F.ws + fwo((unsigned)(WS_X >> 8))));
    f32x4 gg[8], v[8];
#pragma unroll
    for (int j = 0; j < 8; ++j) gg[j] = *(const f32x4*)(g + 4 * lane + 256 * j);
    if (m0 < M) { const GAS f32x4* xr = (const GAS f32x4*)(X + (size_t)m0 * D) + lane;
#pragma unroll
        for (int j = 0; j < 8; ++j) v[j] = xr[64 * j]; }
#pragma unroll 1
    for (int m = m0; m < M; m += F.NGW) { f32x4 nx[8]; const int mn = m + F.NGW;
        if (mn < M) { const GAS f32x4* xr = (const GAS f32x4*)(X + (size_t)mn * D) + lane;
#pragma unroll
            for (int j = 0; j < 8; ++j) nx[j] = xr[64 * j]; }
        if (m >= MP) add_parts(F, m, lane, v);
        float s = 0.f;
#pragma unroll
        for (int j = 0; j < 8; ++j) s += (v[j].x * v[j].x + v[j].y * v[j].y) + (v[j].z * v[j].z + v[j].w * v[j].w);
        const float rstd = rsqrtf(wave_sum(s) * (1.f / D) + 1e-6f);
        GAS f32x4* o = (GAS f32x4*)(F.out + O_YP + (size_t)m * D) + lane;
#pragma unroll
        for (int j = 0; j < 8; ++j) o[64 * j] = v[j] * rstd * gg[j];
#pragma unroll
        for (int j = 0; j < 8; ++j) v[j] = nx[j];
    }
}

struct EpiZ {
    static constexpr bool PERM = true, AFTER_DRAIN = false;
    bf16_t* O; int ldc;
    __device__ __forceinline__ void operator()(const f32x4 (&acc)[2][2][4][2], const pg8::Unit& u, int wr, int wc, int fr_, int fq_) const {
        int fr = fr_, fq = fq_; asm volatile("" : "+v"(fr), "+v"(fq));
        const int row0 = u.pm * 256 + wr * 64 + fr, col0 = u.pn * 256 + wc * 32 + 8 * fq;
#pragma unroll
        for (int ai = 0; ai < 2; ++ai)
#pragma unroll
            for (int m = 0; m < 4; ++m) { bf16_t* rowp = O + (size_t)(row0 + ai * 128 + m * 16) * ldc + col0;
#pragma unroll
                for (int bj = 0; bj < 2; ++bj) { const f32x4 v0 = acc[ai][bj][m][0], v1 = acc[ai][bj][m][1];
                    u32x4 w; w.x = cvt_pk(v0[0], v0[1]); w.y = cvt_pk(v0[2], v0[3]); w.z = cvt_pk(v1[0], v1[1]); w.w = cvt_pk(v1[2], v1[3]);
                    *(u32x4*)(rowp + bj * 128) = w; } }
    }
};
struct EpiMod {
    static constexpr bool PERM = false, AFTER_DRAIN = false;
    float* O; const float* bias;
    __device__ __forceinline__ void operator()(const f32x4 (&acc)[2][2][4][2], const pg8::Unit& u, int wr, int wc, int fr_, int fq_) const {
        int fr = fr_, fq = fq_; asm volatile("" : "+v"(fr), "+v"(fq));
        const int col0 = u.pn * 256 + wc * 32 + 4 * fq; f32x4 bv[2][2];
#pragma unroll
        for (int bj = 0; bj < 2; ++bj)
#pragma unroll
            for (int n = 0; n < 2; ++n) bv[bj][n] = *(const f32x4*)(bias + col0 + bj * 128 + n * 16);
#pragma unroll
        for (int ai = 0; ai < 2; ++ai)
#pragma unroll
            for (int m = 0; m < 4; ++m) { const int row = u.pm * 256 + ai * 128 + wr * 64 + m * 16 + fr;
                if (row < NSEQ) {
#pragma unroll
                    for (int bj = 0; bj < 2; ++bj)
#pragma unroll
                        for (int n = 0; n < 2; ++n) { const int col = col0 + bj * 128 + n * 16; *(f32x4*)(O + (size_t)row * MODLD + col) = acc[ai][bj][m][n] + bv[bj][n]; } } }
    }
};
#ifndef DBG_KEEPNORM
#define DBG_KEEPNORM 0
#endif
struct NormP { const float* g; const float* MOD; int sh, sc; bf16_t* HN; float* Y; const float* PART; unsigned* cnt; unsigned* tmo; LAS unsigned* flag; int on; };
__device__ __forceinline__ void st_wt(float* p, f32x4 v) {
    const f32x2 lo = {v[0], v[1]}, hi = {v[2], v[3]};
    __hip_atomic_store((unsigned long long*)p, __builtin_bit_cast(unsigned long long, lo), __ATOMIC_RELAXED, __HIP_MEMORY_SCOPE_AGENT);
    __hip_atomic_store((unsigned long long*)(p + 2), __builtin_bit_cast(unsigned long long, hi), __ATOMIC_RELAXED, __HIP_MEMORY_SCOPE_AGENT);
}
__device__ __forceinline__ void norm_one_row(const NormP& N, float* X, int m, int lane) {
    float* xrow = X + (size_t)m * D + 4 * lane; f32x4 v[8]; float s = 0.f;
#pragma unroll
    for (int j = 0; j < 8; ++j) v[j] = *(const f32x4*)(xrow + 256 * j);
    if (m >= MP) { const float* P = N.PART + (size_t)(m - MP) * D + 4 * lane;
#pragma unroll
        for (int j = 0; j < 8; ++j) { f32x4 a = v[j];
#pragma unroll
            for (int q = 0; q < SPLIT - 1; ++q) a += *(const f32x4*)(P + (size_t)q * MS * D + 256 * j);
            v[j] = a; *(f32x4*)(xrow + 256 * j) = a; } }
#pragma unroll
    for (int j = 0; j < 8; ++j) s += (v[j].x * v[j].x + v[j].y * v[j].y) + (v[j].z * v[j].z + v[j].w * v[j].w);
    const float rstd = rsqrtf(wave_sum(s) * (1.f / D) + 1e-6f);
    if (N.sh < 0) { float* y = N.Y + (size_t)m * D + 4 * lane;
#pragma unroll
        for (int j = 0; j < 8; ++j) *(f32x4*)(y + 256 * j) = v[j] * rstd * *(const f32x4*)(N.g + 4 * lane + 256 * j); }
    else { const float* mrow = N.MOD + (size_t)row_seq(m) * MODLD; u32x2* o8 = (u32x2*)(N.HN + (size_t)m * D) + lane;
#pragma unroll
        for (int j = 0; j < 8; ++j) { const int c = 4 * lane + 256 * j; const f32x4 gg = *(const f32x4*)(N.g + c), sc = *(const f32x4*)(mrow + N.sc + c), sh = *(const f32x4*)(mrow + N.sh + c);
            const f32x4 y = (v[j] * rstd * gg) * (sc + 1.f) + sh; o8[64 * j] = (u32x2){cvt_pk(y.x, y.y), cvt_pk(y.z, y.w)}; } }
}
struct EpiResGate {
    static constexpr bool PERM = false, AFTER_DRAIN = false;
    float* X; const float* MOD; float* PART; int goff, ks; float* DRY; const float* XP; const float* XS; NormP N;
    __device__ __forceinline__ void operator()(const f32x4 (&acc)[2][2][4][2], const pg8::Unit& u, int wr, int wc, int fr_, int fq_) const {
        int fr = fr_, fq = fq_; asm volatile("" : "+v"(fr), "+v"(fq));
        const int col0 = u.pn * 256 + wc * 32 + 4 * fq; const int slice = u.kb / ks; const bool fused = N.on && !DRY;
        const bool ptile = u.pm < MP / 256;
        if (ptile) {
            const float* mr = MOD + (size_t)(u.pm * 256 / SEQ) * MODLD + goff; f32x4 gm[2][2];
#pragma unroll
            for (int bj = 0; bj < 2; ++bj)
#pragma unroll
                for (int n = 0; n < 2; ++n) gm[bj][n] = *(const f32x4*)(mr + col0 + bj * 128 + n * 16);
#pragma unroll
            for (int ai = 0; ai < 2; ++ai) { f32x4 xo[4][2][2];
#pragma unroll
                for (int m = 0; m < 4; ++m) { const int row = u.pm * 256 + ai * 128 + wr * 64 + m * 16 + fr; const float* xi = DRY ? DRY + (size_t)row * D : (XP ? XP + (size_t)row * D : X + (size_t)row * D);
#pragma unroll
                    for (int bj = 0; bj < 2; ++bj)
#pragma unroll
                        for (int n = 0; n < 2; ++n) xo[m][bj][n] = *(const f32x4*)(xi + col0 + bj * 128 + n * 16); }
#pragma unroll
                for (int m = 0; m < 4; ++m) { const int row = u.pm * 256 + ai * 128 + wr * 64 + m * 16 + fr; float* xr = DRY ? DRY + (size_t)row * D : X + (size_t)row * D;
#pragma unroll
                    for (int bj = 0; bj < 2; ++bj)
#pragma unroll
                        for (int n = 0; n < 2; ++n) { const f32x4 v = xo[m][bj][n] + gm[bj][n] * acc[ai][bj][m][n]; if (fused) st_wt(xr + col0 + bj * 128 + n * 16, v); else *(f32x4*)(xr + col0 + bj * 128 + n * 16) = v; } } }
        } else {
#pragma unroll
            for (int ai = 0; ai < 2; ++ai)
#pragma unroll
                for (int mp = 0; mp < 4; mp += 2) { f32x4 xo[2][2][2], gm[2][2][2];
#pragma unroll
                    for (int mm = 0; mm < 2; ++mm) { const int row = u.pm * 256 + ai * 128 + wr * 64 + (mp + mm) * 16 + fr; const float* mr = MOD + (size_t)row_seq(row) * MODLD + goff;
                        const float* xi = DRY ? DRY + (size_t)row * D : (XS ? XS + (size_t)(row - MP) * D : X + (size_t)row * D);
#pragma unroll
                        for (int bj = 0; bj < 2; ++bj)
#pragma unroll
                            for (int n = 0; n < 2; ++n) { const int col = col0 + bj * 128 + n * 16; gm[mm][bj][n] = *(const f32x4*)(mr + col); xo[mm][bj][n] = (slice == 0) ? *(const f32x4*)(xi + col) : (f32x4){0.f, 0.f, 0.f, 0.f}; } }
#pragma unroll
                    for (int mm = 0; mm < 2; ++mm) { const int row = u.pm * 256 + ai * 128 + wr * 64 + (mp + mm) * 16 + fr;
                        float* xr = DRY ? DRY + (size_t)row * D : (slice == 0 ? X + (size_t)row * D : PART + ((size_t)(slice - 1) * MS + (row - MP)) * D);
#pragma unroll
                        for (int bj = 0; bj < 2; ++bj)
#pragma unroll
                            for (int n = 0; n < 2; ++n) { const int col = col0 + bj * 128 + n * 16; const f32x4 v = xo[mm][bj][n] + gm[mm][bj][n] * acc[ai][bj][mp + mm][n]; if (fused) st_wt(xr + col, v); else *(f32x4*)(xr + col) = v; } } }
        }
        if (fused) {
            const int wave = wr * 4 + wc, lane = fr + 16 * fq; const bool prompt = u.pm < MP / 256; const unsigned target = prompt ? 8u : 8u * SPLIT; unsigned* cw = N.cnt + 64 * u.pm;
            asm volatile("s_waitcnt vmcnt(0)" ::: "memory"); __builtin_amdgcn_s_barrier(); asm volatile("" ::: "memory");
            if (wave == 0) {
                if (lane == 0) (void)__hip_atomic_fetch_add(cw, 1u, __ATOMIC_RELAXED, __HIP_MEMORY_SCOPE_AGENT);
                unsigned sp = 0u;
                while (__hip_atomic_load(cw, __ATOMIC_RELAXED, __HIP_MEMORY_SCOPE_AGENT) < target) { __builtin_amdgcn_s_sleep(2);
                    if ((++sp & 1023u) == 0u) { if (__hip_atomic_load(N.tmo, __ATOMIC_RELAXED, __HIP_MEMORY_SCOPE_AGENT)) break; if (sp > (1u << 22)) { __hip_atomic_store(N.tmo, 1u, __ATOMIC_RELAXED, __HIP_MEMORY_SCOPE_AGENT); break; } } }
                __builtin_amdgcn_fence(__ATOMIC_ACQUIRE, "agent"); asm volatile("s_waitcnt vmcnt(0)" ::: "memory");
            }
            __builtin_amdgcn_s_barrier(); asm volatile("" ::: "memory");
            const int per = prompt ? 32 : 8, q = prompt ? u.pn : u.pn * SPLIT + slice;
            if (!DBG_KEEPNORM) for (int r = wave; r < per; r += 8) norm_one_row(N, X, u.pm * 256 + q * per + r, lane);
        }
    }
};
struct ResOrder {
    int G, c, ntFull, ks;
    __device__ bool next(int i, pg8::Unit& u) const {
        const int L = i * G + c;
        if (L < 256) { const int x = L & 7, y = (L >> 3) & 7, z = L >> 6; u.pm = 8 * (x >> 1) + y; u.pn = 4 * (x & 1) + z; u.kb = 0; u.nt = ntFull; return true; }
        const int q = L - 256; if (q >= 32 * SPLIT) return false;
        const int tile = q / SPLIT, s = q % SPLIT; u.pm = MP / 256 + (tile >> 3); u.pn = tile & 7; u.kb = s * ks; u.nt = ntFull / SPLIT; return true;
    }
    __device__ __forceinline__ void a_ready(const pg8::Unit&) const {}
    __device__ __forceinline__ void done(const pg8::Unit&) const {}
};
template <int N> __device__ __forceinline__ float ror16(float v) { return __builtin_bit_cast(float, __builtin_amdgcn_mov_dpp(__builtin_bit_cast(int, v), 0x120 + N, 0xf, 0xf, true)); }
struct EpiConvFfn {
    static constexpr bool PERM = true, AFTER_DRAIN = false;
    bf16_t* H; float* RAW; const float* cw; const float* cb; float* sbuf; float* sout; LAS float* halo; int skip;
    __device__ __forceinline__ void operator()(const f32x4 (&acc)[2][2][4][2], const pg8::Unit& u, int wr, int wc, int fr_, int fq_) const {
        int fr = fr_, fq = fq_; asm volatile("" : "+v"(fr), "+v"(fq));
        const bool sample = u.pm >= MP / 256;
        const int cc0 = wc * 32 + 8 * fq;
        if (fr >= 14) {
#pragma unroll
            for (int ai = 0; ai < 2; ++ai)
#pragma unroll
                for (int bj = 0; bj < 2; ++bj)
#pragma unroll
                    for (int n = 0; n < 2; ++n) *(LAS f32x4*)(halo + ((((ai * 2 + wr) * 4 + wc) * 2 + (fr - 14)) * 4 + bj * 2 + n) * 16 + 4 * fq) = acc[ai][bj][3][n];
        }
        const int cg0 = u.pn * 128 + cc0;
        f32x4 w0[2], w1[2], w2[2], bb[2];
#pragma unroll
        for (int bj = 0; bj < 2; ++bj) { const int col = bj * D_FF + cg0; w0[bj] = *(const f32x4*)(cw + col); w1[bj] = *(const f32x4*)(cw + 2 * D_FF + col); w2[bj] = *(const f32x4*)(cw + 4 * D_FF + col); bb[bj] = *(const f32x4*)(cb + col); }
        if (!sample) {
            float* rw = RAW + (size_t)u.pm * 4 * (2 * D_FF) + u.pn * 256 + cc0;
            if (wr == 0 && fr < 2) {
#pragma unroll
                for (int bj = 0; bj < 2; ++bj)
#pragma unroll
                    for (int n = 0; n < 2; ++n) *(f32x4*)(rw + (size_t)fr * (2 * D_FF) + bj * 128 + n * 4) = acc[0][bj][0][n]; }
            if (wr == 1 && fr >= 14) {
#pragma unroll
                for (int bj = 0; bj < 2; ++bj)
#pragma unroll
                    for (int n = 0; n < 2; ++n) *(f32x4*)(rw + (size_t)(fr - 12) * (2 * D_FF) + bj * 128 + n * 4) = acc[1][bj][3][n]; }
        }
        asm volatile("s_waitcnt lgkmcnt(0)" ::: "memory"); __builtin_amdgcn_s_barrier(); asm volatile("" ::: "memory");
        if (skip) return;
        u32x2 keep[2][4];
#pragma unroll
        for (int n = 0; n < 2; ++n) {
            if (n == 1) {
#pragma unroll
                for (int bj = 0; bj < 2; ++bj) { const int col = bj * D_FF + cg0 + 4; w0[bj] = *(const f32x4*)(cw + col); w1[bj] = *(const f32x4*)(cw + 2 * D_FF + col); w2[bj] = *(const f32x4*)(cw + 4 * D_FF + col); bb[bj] = *(const f32x4*)(cb + col); } }
#pragma unroll
            for (int ai = 0; ai < 2; ++ai) {
                const bool has_above = (wr == 1) || (ai == 1);
                const int hs = (wr == 1) ? (ai * 2 + 0) : ((ai - 1) * 2 + 1);
#pragma unroll
                for (int m = 0; m < 4; ++m) {
                    const int r = ai * 128 + wr * 64 + m * 16 + fr; const int row = u.pm * 256 + r;
                    f32x4 uu[2];
#pragma unroll
                    for (int bj = 0; bj < 2; ++bj) {
                        const f32x4 x0 = acc[ai][bj][m][n]; f32x4 xm1, xm2;
                        f32x4 h1 = {0.f, 0.f, 0.f, 0.f}, h2 = h1;
                        if (m == 0 && has_above) { h1 = *(const LAS f32x4*)(halo + (((hs * 4 + wc) * 2 + 1) * 4 + bj * 2 + n) * 16 + 4 * fq); h2 = *(const LAS f32x4*)(halo + (((hs * 4 + wc) * 2 + 0) * 4 + bj * 2 + n) * 16 + 4 * fq); }
                        f32x4 s1, s2;
#pragma unroll
                        for (int i = 0; i < 4; ++i) { const float prevm = (m > 0) ? acc[ai][bj][m > 0 ? m - 1 : 0][n][i] : 0.f; s1[i] = (fr == 15) ? prevm : x0[i]; s2[i] = (fr >= 14) ? prevm : x0[i]; }
#pragma unroll
                        for (int i = 0; i < 4; ++i) { xm1[i] = ror16<1>(s1[i]); xm2[i] = ror16<2>(s2[i]); }
                        if (m == 0) {
#pragma unroll
                            for (int i = 0; i < 4; ++i) { xm1[i] = (fr == 0) ? h1[i] : xm1[i]; xm2[i] = (fr == 0) ? h2[i] : ((fr == 1) ? h1[i] : xm2[i]); } }
                        if (sample) {
                            const int t = fr & 7; const int bs = (row - MP) >> 3; const int col = bj * D_FF + cg0 + 4 * n;
                            if (t < 2) *(f32x4*)(sbuf + ((size_t)bs * 2 + t) * (2 * D_FF) + col) = x0;
                            if (t >= 6) *(f32x4*)(sout + ((size_t)bs * 2 + (t - 6)) * (2 * D_FF) + col) = x0;
                        }
                        uu[bj] = w0[bj] * xm2 + w1[bj] * xm1 + w2[bj] * x0 + bb[bj];
                    }
                    const u32x2 pk = {cvt_pk(siluf(uu[0][0]) * uu[1][0], siluf(uu[0][1]) * uu[1][1]), cvt_pk(siluf(uu[0][2]) * uu[1][2], siluf(uu[0][3]) * uu[1][3])};
                    if (n == 0) keep[ai][m] = pk;
                    else *(u32x4*)(H + (size_t)row * D_FF + cg0) = (u32x4){keep[ai][m].x, keep[ai][m].y, pk.x, pk.y};
                }
            }
            asm volatile("" ::: "memory");
        }
    }
};
template <int KIND> struct MK {
    static constexpr int DK = KIND ? DK_RET : DK_GLA, DV = KIND ? DV_RET : DV_GLA;
    static constexpr int QO = KIND ? F_RQ : F_GQ, KO = KIND ? F_RK : F_GK, VO = KIND ? F_RV : F_GV, GO = KIND ? F_RG : F_GG, MO = KIND ? (W_GLA + W_LRU) : 0;
    static constexpr int RSK = DK * 2 + 16, RSV = DV * 2 + 16, NKS = DK / 32, NJB = DV / 16;
    static constexpr float QSCALE = KIND ? 0.08838834764831845f : 0.10206207261596575f;
};
constexpr int HTHR = 256, HALF_LDS = 73728;
constexpr int L_QD = 0, L_KD = 17408, L_V = 34816, L_ATT = 60416, L_GLR = L_ATT  , L_BQ = 69632, RSA = 144;
static_assert(L_BQ + 2048 <= HALF_LDS && 2 * HALF_LDS <= MISC_OFF, "half LDS map");
__device__ __forceinline__ unsigned lds_addr(LAS const void* p) { return (unsigned)(unsigned long)p; }
__device__ __forceinline__ f32x4 mma(bf16x8 first, bf16x8 second, f32x4 c) { return __builtin_amdgcn_mfma_f32_16x16x32_bf16(first, second, c, 0, 0, 0); }
__device__ __forceinline__ unsigned pk_rne(float lo, float hi) { unsigned a = __builtin_bit_cast(unsigned, lo), b = __builtin_bit_cast(unsigned, hi); a += 0x7fffu + ((a >> 16) & 1u); b += 0x7fffu + ((b >> 16) & 1u); return (a >> 16) | (b & 0xffff0000u); }
__device__ __forceinline__ bf16x8 row_frag(LAS const unsigned char* img, int RS, int row, int k0) { return *(const LAS bf16x8*)(img + row * RS + k0 * 2); }
template <int RS> __device__ __forceinline__ bf16x8 tr_frag(LAS const unsigned char* img, int kbase, int colbase, int fr, int fq) {
    const unsigned a = lds_addr(img) + (unsigned)((kbase + 8 * fq + (fr >> 2)) * RS + (colbase + 4 * (fr & 3)) * 2);
    s16x4 lo, hi;
    asm volatile("ds_read_b64_tr_b16 %0, %2\n\tds_read_b64_tr_b16 %1, %2 offset:%3\n\ts_waitcnt lgkmcnt(0)" : "=&v"(lo), "=&v"(hi) : "v"(a), "i"(4 * RS) : "memory");
    return (bf16x8){lo[0], lo[1], lo[2], lo[3], hi[0], hi[1], hi[2], hi[3]};
}
__device__ __forceinline__ float ret_logg(int h) { return log1pf(-exp2f(-5.f - (float)h)); }

struct Half { LAS unsigned char* lds; LAS unsigned* cnt; unsigned tgt; int hid; };
__device__ __forceinline__ void hbar(Half& H, int lane) {
    asm volatile("s_waitcnt lgkmcnt(0)" ::: "memory");
    H.tgt += 4u;
    if (lane == 0) (void)__hip_atomic_fetch_add(H.cnt, 1u, __ATOMIC_RELAXED, __HIP_MEMORY_SCOPE_WORKGROUP);
    while (__hip_atomic_load(H.cnt, __ATOMIC_RELAXED, __HIP_MEMORY_SCOPE_WORKGROUP) < H.tgt) __builtin_amdgcn_s_sleep(1);
    asm volatile("" ::: "memory");
}
struct LP { const float *gwa, *gba, *gng, *rng, *lcw, *lcb, *lba, *lbx, *spl, *sgla, *sret, *slru, *slconv; };

template <int KIND, int MODE> __device__ __forceinline__ void mix_prompt_unit(Frame& F, Half& H, const LP& P, int l, int b, int c, int h) {
    typedef MK<KIND> K; constexpr int DK = K::DK, DV = K::DV, RSK = K::RSK, RSV = K::RSV;
    const int lane = fresh_lane(), wid = fresh_s(F.wave) & 3, tid = wid * 64 + lane, fr = lane & 15, fq = lane >> 4;
    LAS unsigned char* lds = H.lds;
    const size_t row0 = (size_t)b * SEQ + 64 * c;
    const bf16_t* zr = ((bf16_t*)(F.ws + fwo((unsigned)(WS_Z >> 8)))) + row0 * ZLD;
    const size_t ubase = ((size_t)(b * NCH + c) * 4 + h);
    if (KIND == 0 && tid < 128) { const int t = tid >> 1, hf = tid & 1; const u32x4 w = *(const u32x4*)(zr + (size_t)t * ZLD + F_GLR + 8 * hf); LAS float* g = (LAS float*)(lds + L_GLR) + t * 16 + 8 * hf;
        g[0] = bflo(w.x); g[1] = bfhi(w.x); g[2] = bflo(w.y); g[3] = bfhi(w.y); g[4] = bflo(w.z); g[5] = bfhi(w.z); g[6] = bflo(w.w); g[7] = bfhi(w.w); }
    for (int it = tid; it < 64 * (DV / 8); it += HTHR) { const int s = it / (DV / 8), jo = (it % (DV / 8)) * 8;
        *(LAS u32x4*)(lds + L_V + s * RSV + jo * 2) = *(const u32x4*)(zr + (size_t)s * ZLD + K::VO + h * DV + jo); }
    for (int it = tid; it < 64 * (DK / 8); it += HTHR) { const int s = it / (DK / 8), jo = (it % (DK / 8)) * 8;
        *(LAS u32x4*)(lds + L_KD + s * RSK + jo * 2) = *(const u32x4*)(zr + (size_t)s * ZLD + K::KO + h * DK + jo);
        if (MODE == 1) *(LAS u32x4*)(lds + L_QD + s * RSK + jo * 2) = *(const u32x4*)(zr + (size_t)s * ZLD + K::QO + h * DK + jo); }
    u32x2 gtv[K::NJB]; f32x4 g4v[K::NJB];
    if (MODE == 1) { const bf16_t* ztp = zr + (size_t)(16 * wid + fr) * ZLD + K::GO + h * DV; const float* ngp = (KIND ? P.rng : P.gng) + h * DV;
#pragma unroll
        for (int jb = 0; jb < K::NJB; ++jb) { const int j0 = 16 * jb + 4 * fq; gtv[jb] = *(const u32x2*)(ztp + j0); g4v[jb] = *(const f32x4*)(ngp + j0); } }
    hbar(H, lane);
    float blast = 0.f;
    if (F.umask & 0x200) {} else
    if (KIND == 0) {
        const int d = tid % DK, th = tid / DK; const bool act = tid < 2 * DK; float cb[32];
        if (act) { float wcol[16]; const float* wa = P.gwa + h * DK + d;
#pragma unroll
            for (int r = 0; r < 16; ++r) wcol[r] = wa[r * 384];
            const float bias = P.gba[h * DK + d]; float cum = 0.f;
#pragma unroll
            for (int tt = 0; tt < 32; ++tt) { const LAS f32x4* g = (const LAS f32x4*)(lds + L_GLR) + (32 * th + tt) * 4; float u = bias;
#pragma unroll
                for (int r4 = 0; r4 < 4; ++r4) { const f32x4 gv = g[r4]; u += gv[0] * wcol[4 * r4] + gv[1] * wcol[4 * r4 + 1] + gv[2] * wcol[4 * r4 + 2] + gv[3] * wcol[4 * r4 + 3]; }
                cum += logsig(u) * (1.f / 16.f); cb[tt] = cum; }
            ((LAS float*)(lds + L_BQ))[th * 128 + d] = cum; }
        hbar(H, lane);
        if (act) { const LAS float* bq = (const LAS float*)(lds + L_BQ); const float v0 = bq[d], v1 = bq[128 + d]; blast = v0 + v1; const float pre = th ? v0 : 0.f;
#pragma unroll
            for (int tt = 0; tt < 32; ++tt) { const int t = 32 * th + tt; const float bt = pre + cb[tt];
                LAS bf16_t* kp = (LAS bf16_t*)(lds + L_KD + t * RSK) + d; const float k = bf2f(*kp);
                if (MODE == 1) { LAS bf16_t* qp = (LAS bf16_t*)(lds + L_QD + t * RSK) + d; const float q = bf2f(*qp); *qp = f2bf(q * K::QSCALE * fexp(bt)); *kp = f2bf(k * fexp(-bt)); }
                else *kp = f2bf(k * fexp(blast - bt)); }
            if (MODE == 0 && th == 0) ((float*)(F.ws + fwo((unsigned)(WS_DECG >> 8))))[ubase * DK + d] = fexp(blast); }
    } else {
        const int i = tid & 63, tq = tid >> 6; const float lg = ret_logg(h); blast = 64.f * lg;
        const f32x2* rope = ((const f32x2*)((float*)(F.ws + fwo((unsigned)(WS_ROPE >> 8))))) + (size_t)(64 * c + 16 * tq) * 64 + i; f32x2 cs[16];
#pragma unroll
        for (int tt = 0; tt < 16; ++tt) cs[tt] = rope[tt * 64];
#pragma unroll
        for (int tt = 0; tt < 16; ++tt) { const int t = 16 * tq + tt; const float bt = (float)(t + 1) * lg;
            LAS bf16_t* kp = (LAS bf16_t*)(lds + L_KD + t * RSK) + i; const float k1 = bf2f(kp[0]), k2 = bf2f(kp[64]); const float kr1 = k1 * cs[tt].x - k2 * cs[tt].y, kr2 = k1 * cs[tt].y + k2 * cs[tt].x;
            if (MODE == 1) { LAS bf16_t* qp = (LAS bf16_t*)(lds + L_QD + t * RSK) + i; const float q1 = bf2f(qp[0]), q2 = bf2f(qp[64]); const float e = K::QSCALE * fexp(bt), ek = fexp(-bt);
                qp[0] = f2bf((q1 * cs[tt].x - q2 * cs[tt].y) * e); qp[64] = f2bf((q1 * cs[tt].y + q2 * cs[tt].x) * e); kp[0] = f2bf(kr1 * ek); kp[64] = f2bf(kr2 * ek); }
            else { const float ek = fexp(blast - bt); kp[0] = f2bf(kr1 * ek); kp[64] = f2bf(kr2 * ek); } }
    }
    hbar(H, lane);
    if (F.umask & 0x400) {} else
    if (MODE == 0) {
        constexpr int NDB = DK / 16, JPW = K::NJB / 4;
        bf16_t* DS = (KIND ? ((bf16_t*)(F.ws + fwo((unsigned)(WS_DSR >> 8)))) : ((bf16_t*)(F.ws + fwo((unsigned)(WS_DSG >> 8))))) + ubase * (size_t)(DV * DK);
#pragma unroll 1
        for (int q = 0; q < JPW; ++q) { const int jb = wid * JPW + q;
            const bf16x8 a0 = tr_frag<RSV>(lds + L_V, 0, 16 * jb, fr, fq), a1 = tr_frag<RSV>(lds + L_V, 32, 16 * jb, fr, fq);
#pragma unroll 2
            for (int db = 0; db < NDB; ++db) { const bf16x8 b0 = tr_frag<RSK>(lds + L_KD, 0, 16 * db, fr, fq), b1 = tr_frag<RSK>(lds + L_KD, 32, 16 * db, fr, fq);
                f32x4 acc = {0.f, 0.f, 0.f, 0.f}; acc = mma(b0, a0, acc); acc = mma(b1, a1, acc);
                *(u32x2*)(DS + (size_t)(16 * jb + fr) * DK + 16 * db + 4 * fq) = (u32x2){pk_rne(acc[0], acc[1]), pk_rne(acc[2], acc[3])}; } }
    } else {
#pragma unroll 1
        for (int p = wid; p < 12; p += 4) { f32x4 acc = {0.f, 0.f, 0.f, 0.f};
            if (p >= 10) { const int tb = p == 10 ? 0 : 2, sb = tb + 1; *(LAS u32x2*)(lds + L_ATT + (16 * tb + fr) * RSA + (16 * sb + 4 * fq) * 2) = (u32x2){0u, 0u}; continue; }
            const int tb = p >= 6 ? 3 : (p >= 3 ? 2 : (p >= 1 ? 1 : 0)), sb = p - tb * (tb + 1) / 2;
#pragma unroll
            for (int ks = 0; ks < K::NKS; ++ks) { const bf16x8 a = row_frag(lds + L_QD, RSK, 16 * tb + fr, 32 * ks + 8 * fq), bt = row_frag(lds + L_KD, RSK, 16 * sb + fr, 32 * ks + 8 * fq); acc = mma(bt, a, acc); }
            if (sb == tb) {
#pragma unroll
                for (int i = 0; i < 4; ++i) if (4 * fq + i > fr) acc[i] = 0.f; }
            *(LAS u32x2*)(lds + L_ATT + (16 * tb + fr) * RSA + (16 * sb + 4 * fq) * 2) = (u32x2){pk_rne(acc[0], acc[1]), pk_rne(acc[2], acc[3])}; }
        hbar(H, lane);
        const int tb = wid; f32x4 acc[K::NJB];
#pragma unroll
        for (int jb = 0; jb < K::NJB; ++jb) acc[jb] = (f32x4){0.f, 0.f, 0.f, 0.f};
        const int nksa = tb >= 2 ? 2 : 1;
#pragma unroll 1
        for (int ks = 0; ks < nksa; ++ks) { const bf16x8 a = row_frag(lds + L_ATT, RSA, 16 * tb + fr, 32 * ks + 8 * fq);
#pragma unroll
            for (int jb = 0; jb < K::NJB; ++jb) { const bf16x8 bt = tr_frag<RSV>(lds + L_V, 32 * ks, 16 * jb, fr, fq); acc[jb] = mma(bt, a, acc[jb]); } }
        if (c > 0) { const bf16_t* SS = (KIND ? ((bf16_t*)(F.ws + fwo((unsigned)(WS_SSR >> 8)))) : ((bf16_t*)(F.ws + fwo((unsigned)(WS_SSG >> 8))))) + ubase * (size_t)(DV * DK);
#pragma unroll
            for (int ks = 0; ks < K::NKS; ++ks) { const bf16x8 a = row_frag(lds + L_QD, RSK, 16 * tb + fr, 32 * ks + 8 * fq);
#pragma unroll
                for (int jb = 0; jb < K::NJB; ++jb) { const bf16x8 bt = *(const bf16x8*)(SS + (size_t)(16 * jb + fr) * DK + 32 * ks + 8 * fq); acc[jb] = mma(bt, a, acc[jb]); } } }
        float ss = 0.f;
#pragma unroll
        for (int jb = 0; jb < K::NJB; ++jb) ss += (acc[jb][0] * acc[jb][0] + acc[jb][1] * acc[jb][1]) + (acc[jb][2] * acc[jb][2] + acc[jb][3] * acc[jb][3]);
        ss += __shfl_xor(ss, 16); ss += __shfl_xor(ss, 32);
        const int t = 16 * tb + fr; const float rstd = rsqrtf(ss * (1.f / DV) + 1e-6f);
        bf16_t* mo = ((bf16_t*)(F.ws + fwo((unsigned)(WS_MIX >> 8)))) + (row0 + t) * D + K::MO + h * DV;
#pragma unroll
        for (int jb = 0; jb < K::NJB; ++jb) { const int j0 = 16 * jb + 4 * fq; const f32x4 g4 = g4v[jb]; const u32x2 gt = gtv[jb];
            const f32x4 y = {acc[jb][0] * rstd * g4[0] * siluf(bflo(gt.x)), acc[jb][1] * rstd * g4[1] * siluf(bfhi(gt.x)), acc[jb][2] * rstd * g4[2] * siluf(bflo(gt.y)), acc[jb][3] * rstd * g4[3] * siluf(bfhi(gt.y))};
            *(u32x2*)(mo + j0) = (u32x2){cvt_pk(y[0], y[1]), cvt_pk(y[2], y[3])}; }
    }
    hbar(H, lane);
}

template <int KIND> __device__ __forceinline__ void mix_sample_unit(Frame& F, Half& H, const LP& P, int l, int bs, int h) {
    typedef MK<KIND> K; constexpr int DK = K::DK, DV = K::DV, J4 = DV / 4, NG = KIND ? 8 : 4, DPG = DK / NG;
    const int lane = fresh_lane(), wid = fresh_s(F.wave) & 3, tid = wid * 64 + lane;
    LAS float* Q = (LAS float*)H.lds;
    LAS float* KX = Q + 1024;
    LAS float* BC = KX + 1024;
    LAS float* QDT = BC + 1024;
    LAS float* KKT = QDT + 1024;
    LAS float* EBL = KKT + 1024;
    LAS float* V = EBL + 128;
    LAS float* ATT = V + 1536;
    LAS float* OP = ATT + 64;
    const size_t row0 = (size_t)MP + 8 * bs; const bf16_t* zr = ((bf16_t*)(F.ws + fwo((unsigned)(WS_Z >> 8)))) + row0 * ZLD;
    const size_t sbase = (((size_t)l * DEC_BATCH + bs) * 4 + h) * (size_t)(DK * DV); const int j4 = tid % J4, grp = tid / J4; const bool sact = tid < NG * J4;
    const float* S0 = (KIND ? P.sret : P.sgla) + sbase;
    f32x4 s0v[DPG];
    if (sact) {
#pragma unroll
        for (int dd = 0; dd < DPG; ++dd) s0v[dd] = __builtin_nontemporal_load((const f32x4*)(S0 + (size_t)(grp * DPG + dd) * DV + 4 * j4)); }
    for (int i = tid; i < 8 * DV; i += HTHR) { const int t = i / DV, j = i % DV; V[t * 192 + j] = bf2f(zr[(size_t)t * ZLD + K::VO + h * DV + j]); }
    if (tid < DK) { const int d = tid; float wcol[16]; float bias = 0.f;
        if (KIND == 0) { const float* wa = P.gwa + h * DK + d;
#pragma unroll
            for (int r = 0; r < 16; ++r) wcol[r] = wa[r * 384];
            bias = P.gba[h * DK + d]; }
        const float lg = KIND ? ret_logg(h) : 0.f; float cum = 0.f; float bt[8], qv[8], kv[8];
#pragma unroll
        for (int t = 0; t < 8; ++t) { const bf16_t* zt = zr + (size_t)t * ZLD;
            if (KIND == 0) { float u = bias; const u32x4 g0 = *(const u32x4*)(zt + F_GLR), g1 = *(const u32x4*)(zt + F_GLR + 8);
                u += bflo(g0.x) * wcol[0] + bfhi(g0.x) * wcol[1] + bflo(g0.y) * wcol[2] + bfhi(g0.y) * wcol[3] + bflo(g0.z) * wcol[4] + bfhi(g0.z) * wcol[5] + bflo(g0.w) * wcol[6] + bfhi(g0.w) * wcol[7];
                u += bflo(g1.x) * wcol[8] + bfhi(g1.x) * wcol[9] + bflo(g1.y) * wcol[10] + bfhi(g1.y) * wcol[11] + bflo(g1.z) * wcol[12] + bfhi(g1.z) * wcol[13] + bflo(g1.w) * wcol[14] + bfhi(g1.w) * wcol[15];
                cum += logsig(u) * (1.f / 16.f); qv[t] = bf2f(zt[K::QO + h * DK + d]); kv[t] = bf2f(zt[K::KO + h * DK + d]); }
            else { cum += lg; const int i = d & 63; const f32x2 cs = ((const f32x2*)((float*)(F.ws + fwo((unsigned)(WS_ROPE >> 8)))))[(size_t)(SEQ + t) * 64 + i];
                const float q1 = bf2f(zt[K::QO + h * DK + i]), q2 = bf2f(zt[K::QO + h * DK + 64 + i]), k1 = bf2f(zt[K::KO + h * DK + i]), k2 = bf2f(zt[K::KO + h * DK + 64 + i]);
                qv[t] = d < 64 ? q1 * cs.x - q2 * cs.y : q1 * cs.y + q2 * cs.x; kv[t] = d < 64 ? k1 * cs.x - k2 * cs.y : k1 * cs.y + k2 * cs.x; }
            bt[t] = cum; }
        f32x4 qa, qb, ka, kb;
#pragma unroll
        for (int t = 0; t < 8; ++t) { Q[t * 128 + d] = qv[t] * K::QSCALE; KX[t * 128 + d] = kv[t]; BC[t * 128 + d] = bt[t];
            const float qd = qv[t] * K::QSCALE * fexp(bt[t]), kk = kv[t] * fexp(cum - bt[t]); if (t < 4) { qa[t] = qd; ka[t] = kk; } else { qb[t - 4] = qd; kb[t - 4] = kk; } }
        *(LAS f32x4*)(QDT + d * 8) = qa; *(LAS f32x4*)(QDT + d * 8 + 4) = qb; *(LAS f32x4*)(KKT + d * 8) = ka; *(LAS f32x4*)(KKT + d * 8 + 4) = kb;
        EBL[d] = fexp(cum); }
    hbar(H, lane);
    { const int pair = tid >> 2, part = tid & 3, t = pair >> 3, s = pair & 7; float a = 0.f;
      if (s <= t) for (int d = part; d < DK; d += 4) a += Q[t * 128 + d] * KX[s * 128 + d] * fexp(BC[t * 128 + d] - BC[s * 128 + d]);
      a += __shfl_xor(a, 1); a += __shfl_xor(a, 2);
      if (part == 0) ATT[t * 8 + s] = a; }
    hbar(H, lane);
    if (sact) { f32x4 v[8], op[8];
#pragma unroll
        for (int t = 0; t < 8; ++t) { v[t] = *(const LAS f32x4*)(V + t * 192 + 4 * j4); op[t] = (f32x4){0.f, 0.f, 0.f, 0.f}; }
        float* S1 = F.out + (KIND ? O_RET_S : O_GLA_S) + sbase;
#pragma unroll
        for (int dd = 0; dd < DPG; ++dd) { const int d = grp * DPG + dd; const f32x4 s0 = s0v[dd];
            const f32x4 ka = *(const LAS f32x4*)(KKT + d * 8), kb = *(const LAS f32x4*)(KKT + d * 8 + 4), qa = *(const LAS f32x4*)(QDT + d * 8), qb = *(const LAS f32x4*)(QDT + d * 8 + 4);
            f32x4 sn = s0 * EBL[d];
#pragma unroll
            for (int t = 0; t < 4; ++t) { sn += v[t] * ka[t]; sn += v[t + 4] * kb[t]; op[t] += s0 * qa[t]; op[t + 4] += s0 * qb[t]; }
            __builtin_nontemporal_store(sn, (f32x4*)(S1 + (size_t)d * DV + 4 * j4));
            if ((dd & 3) == 3) asm volatile("" ::: "memory"); }
        if (grp == 0) {
#pragma unroll
            for (int t = 0; t < 8; ++t)
#pragma unroll
                for (int s = 0; s < 8; ++s) if (s <= t) op[t] += v[s] * ATT[t * 8 + s]; }
#pragma unroll
        for (int t = 0; t < 8; ++t) *(LAS f32x4*)(OP + (grp * 8 + t) * DV + 4 * j4) = op[t]; }
    hbar(H, lane);
    const float* ng = (KIND ? P.rng : P.gng) + h * DV;
    { float gz[2][3], gn[3];
#pragma unroll
      for (int k = 0; k < DV / 64; ++k) { gn[k] = ng[lane + 64 * k];
#pragma unroll
          for (int tk = 0; tk < 2; ++tk) gz[tk][k] = bf2f(zr[(size_t)(wid + 4 * tk) * ZLD + K::GO + h * DV + lane + 64 * k]); }
#pragma unroll
      for (int tk = 0; tk < 2; ++tk) { const int t = wid + 4 * tk; float o[3]; float ss = 0.f;
#pragma unroll
        for (int k = 0; k < DV / 64; ++k) { const int j = lane + 64 * k; float a = 0.f;
#pragma unroll
            for (int g = 0; g < NG; ++g) a += OP[(g * 8 + t) * DV + j];
            o[k] = a; ss += a * a; }
        const float rstd = rsqrtf(wave_sum(ss) * (1.f / DV) + 1e-6f);
        bf16_t* mo = ((bf16_t*)(F.ws + fwo((unsigned)(WS_MIX >> 8)))) + (row0 + t) * D + K::MO + h * DV;
#pragma unroll
        for (int k = 0; k < DV / 64; ++k) { const int j = lane + 64 * k; mo[j] = f2bf(o[k] * rstd * gn[k] * siluf(gz[tk][k])); } } }
    hbar(H, lane);
}

constexpr int LL_XE = 0, LL_XC = 33792, LL_LA = 47104, LL_PH = LL_XC  , RSX = 208;
static_assert(LL_LA + 24576 <= HALF_LDS, "LRU LDS map");
__device__ __forceinline__ float neg_expm1(float x) {
    const float s = x * (1.f + x * (0.5f + x * (0.16666667f + x * (0.041666668f + x * (0.0083333338f + x * 0.0013888889f))))); return x > -0.25f ? -s : 1.f - __expf(x); }
template <int MODE, bool SAMPLE> __device__ __forceinline__ void lru_unit(Frame& F, Half& H, const LP& P, int l, int rc, int g) {
    const int lane = fresh_lane(), wid = fresh_s(F.wave) & 3, tid = wid * 64 + lane, fr = lane & 15, fq = lane >> 4;
    LAS unsigned char* lds = H.lds; LAS float* XE = (LAS float*)(lds + LL_XE); LAS float* U = XE; LAS float* LA = (LAS float*)(lds + LL_LA); LAS float* PH = (LAS float*)(lds + LL_PH);
    constexpr bool sample = SAMPLE; constexpr int L = SAMPLE ? 8 : 64, nseg = SAMPLE ? 8 : 1;
    const size_t row0 = (size_t)rc * 64; const bf16_t* zb = ((bf16_t*)(F.ws + fwo((unsigned)(WS_Z >> 8)))) + row0 * ZLD; const bf16_t* zr = zb + F_LX + g * 96;
    const int pb = rc / NCH, pc = rc % NCH;
    for (int it = tid; it < nseg * (L + 3) * 12; it += HTHR) { const int ir = it / 12, c8 = (it % 12) * 8; const int seg = ir / (L + 3), tp = ir % (L + 3) - 3;
        LAS float* dst = XE + ir * 96 + c8; f32x4 lo = {0.f, 0.f, 0.f, 0.f}, hi = lo;
        if (tp >= 0 || (!sample && pc > 0)) { const u32x4 w = *(const u32x4*)(zr + ((long)seg * L + tp) * (long)ZLD + c8); lo = (f32x4){bflo(w.x), bfhi(w.x), bflo(w.y), bfhi(w.y)}; hi = (f32x4){bflo(w.z), bfhi(w.z), bflo(w.w), bfhi(w.w)}; }
        else if (sample) { const int bs = (rc - MP / 64) * 8 + seg; const float* sb = P.slconv + ((size_t)bs * 3 + (tp + 3)) * W_LRU + g * 96 + c8; lo = *(const f32x4*)sb; hi = *(const f32x4*)(sb + 4); }
        *(LAS f32x4*)dst = lo; *(LAS f32x4*)(dst + 4) = hi; }
    hbar(H, lane);
    LAS float* XF = LA;
    if (tid < 192) { const int ch = tid % 96, ts = tid / 96; const float* cw = P.lcw + g * 96 + ch; const float w0 = cw[0], w1 = cw[W_LRU], w2 = cw[2 * W_LRU], w3 = cw[3 * W_LRU], cbv = P.lcb[g * 96 + ch];
#pragma unroll 4
        for (int k = 0; k < 32; ++k) { const int t = ts + 2 * k; const int ir = (t / L) * (L + 3) + 3 + (t % L);
            const float xc = w0 * XE[(ir - 3) * 96 + ch] + w1 * XE[(ir - 2) * 96 + ch] + w2 * XE[(ir - 1) * 96 + ch] + w3 * XE[ir * 96 + ch] + cbv;
            XF[t * 96 + ch] = xc; ((LAS bf16_t*)(lds + LL_XC + t * RSX))[ch] = f2bf(xc); }
        if (ts == 0 && (sample ? MODE == 1 : MODE == 0)) {
            if (!sample) { if (pc == NCH - 1) {
#pragma unroll
                for (int k = 0; k < 3; ++k) F.out[O_LCONV_P + (((size_t)l * BATCH + pb) * 3 + k) * W_LRU + g * 96 + ch] = XE[(3 + 61 + k) * 96 + ch]; } }
            else {
#pragma unroll 1
                for (int seg = 0; seg < 8; ++seg) { const int bs = (rc - MP / 64) * 8 + seg;
#pragma unroll
                    for (int k = 0; k < 3; ++k) F.out[O_LCONV_S + (((size_t)l * DEC_BATCH + bs) * 3 + k) * W_LRU + g * 96 + ch] = XE[(seg * 11 + 3 + 5 + k) * 96 + ch]; } } } }
    hbar(H, lane);
    { const int tb = wid; f32x4 acc[2][6];
#pragma unroll
      for (int m = 0; m < 2; ++m)
#pragma unroll
          for (int jb = 0; jb < 6; ++jb) acc[m][jb] = (f32x4){0.f, 0.f, 0.f, 0.f};
      const bf16_t* WT = ((bf16_t*)(F.ws + fwo((unsigned)(WS_LRUW >> 8)))) + ((((size_t)l * 2) * 8 + g) * 96) * 96;
#pragma unroll 1
      for (int ks = 0; ks < 3; ++ks) { const bf16x8 a = row_frag(lds + LL_XC, RSX, 16 * tb + fr, 32 * ks + 8 * fq);
#pragma unroll
          for (int m = 0; m < 2; ++m)
#pragma unroll
              for (int jb = 0; jb < 6; ++jb) { const bf16x8 bt = *(const bf16x8*)(WT + (size_t)m * (8 * 96 * 96) + (size_t)(16 * jb + fr) * 96 + 32 * ks + 8 * fq); acc[m][jb] = mma(bt, a, acc[m][jb]); } }
      const int t = 16 * tb + fr; const float* ba = P.lba + g * 96; const float* bx = P.lbx + g * 96; const float* sp = P.spl + g * 96;
#pragma unroll
      for (int jb = 0; jb < 6; ++jb) { const int j0 = 16 * jb + 4 * fq; const f32x4 bav = *(const f32x4*)(ba + j0), bxv = *(const f32x4*)(bx + j0), spv = *(const f32x4*)(sp + j0); const f32x4 xf = *(const LAS f32x4*)(XF + t * 96 + j0); f32x4 o, u;
#pragma unroll
          for (int i = 0; i < 4; ++i) { const float la = -LRU_C * sigm(acc[0][jb][i] + bav[i]) * spv[i]; o[i] = fexp(la); u[i] = __builtin_amdgcn_sqrtf(neg_expm1(2.f * la)) * sigm(acc[1][jb][i] + bxv[i]) * xf[i]; }
          *(LAS f32x4*)(LA + t * 96 + j0) = o; *(LAS f32x4*)(U + t * 96 + j0) = u; } }
    hbar(H, lane);
    const int ch = tid % 96, qh = tid / 96; const bool act = tid < 192;
    float Pp = 1.f, Hh = 0.f;
    if (act && !sample) {
        unsigned* ag = ((unsigned*)(F.ws + fwo((unsigned)(WS_LAG >> 8)))) + (row0 + 32 * qh) * W_LRU + g * 96 + ch;
#pragma unroll 8
        for (int tt = 0; tt < 32; ++tt) { const int idx = (32 * qh + tt) * 96 + ch; const float a = LA[idx], u = U[idx]; Hh = a * Hh + u; Pp *= a;
            if (MODE == 0) ag[(size_t)tt * W_LRU] = pk_rne(__builtin_amdgcn_logf(a), u); }
    }
    bf16_t* mo = ((bf16_t*)(F.ws + fwo((unsigned)(WS_MIX >> 8)))) + row0 * D + W_GLA + g * 96 + ch; const bf16_t* zg = zb + F_LG + g * 96 + ch;
    if (!sample) {
        if (act) { PH[(qh * 96 + ch) * 2] = Pp; PH[(qh * 96 + ch) * 2 + 1] = Hh; }
        hbar(H, lane);
        if (act) {
            const size_t sidx = ((size_t)(pb * NCH + pc)) * W_LRU + g * 96 + ch;
            float hc = (MODE == 1) ? ((float*)(F.ws + fwo((unsigned)(WS_LHS >> 8))))[sidx] : 0.f;
            if (qh == 1) hc = PH[ch * 2] * hc + PH[ch * 2 + 1];
            if (MODE == 0) { if (qh == 1) { float* lab = ((float*)(F.ws + fwo((unsigned)(WS_LAB >> 8)))); lab[sidx * 2] = PH[ch * 2] * Pp; lab[sidx * 2 + 1] = Pp * hc + Hh; } }
            else {
                bf16_t gv[32];
#pragma unroll
                for (int tt = 0; tt < 32; ++tt) gv[tt] = zg[(size_t)(32 * qh + tt) * ZLD];
#pragma unroll
                for (int tt = 0; tt < 32; ++tt) { const int t = 32 * qh + tt; hc = LA[t * 96 + ch] * hc + U[t * 96 + ch]; mo[(size_t)t * D] = f2bf(hc * gelu_t(bf2f(gv[tt]))); }
                if (pc == NCH - 1 && qh == 1) F.out[O_LRU_P + ((size_t)l * BATCH + pb) * W_LRU + g * 96 + ch] = hc; }
        }
    } else if (MODE == 1) {
        if (act) {
            bf16_t gv[32]; float h0v[4];
#pragma unroll
            for (int tt = 0; tt < 32; ++tt) gv[tt] = zg[(size_t)(32 * qh + tt) * ZLD];
#pragma unroll
            for (int sg = 0; sg < 4; ++sg) h0v[sg] = P.slru[(size_t)((rc - MP / 64) * 8 + 4 * qh + sg) * W_LRU + g * 96 + ch];
#pragma unroll
            for (int sg = 0; sg < 4; ++sg) { const int seg = 4 * qh + sg; const int bs = (rc - MP / 64) * 8 + seg; const size_t si = (size_t)bs * W_LRU + g * 96 + ch;
                float hc = h0v[sg];
#pragma unroll
                for (int tt = 0; tt < 8; ++tt) { const int t = 8 * seg + tt; hc = LA[t * 96 + ch] * hc + U[t * 96 + ch]; mo[(size_t)t * D] = f2bf(hc * gelu_t(bf2f(gv[8 * sg + tt]))); }
                F.out[O_LRU_S + (size_t)l * DEC_BATCH * W_LRU + si] = hc; } }
    }
    hbar(H, lane);
}

__device__ __forceinline__ void lru_out_unit(Frame& F, Half& H, const LP& P, int l, int rc, int g) {
    const int lane = fresh_lane(), wid = fresh_s(F.wave) & 3, tid = wid * 64 + lane;
    LAS float* PH = (LAS float*)H.lds;
    const int ch = tid % 96, qh = tid / 96; const bool act = tid < 192; const int pb = rc / NCH, pc = rc % NCH; const size_t row0 = (size_t)rc * 64;
    unsigned wv[32]; bf16_t gv[32]; float hs = 0.f;
    if (act) { const unsigned* ag = ((const unsigned*)(F.ws + fwo((unsigned)(WS_LAG >> 8)))) + (row0 + 32 * qh) * W_LRU + g * 96 + ch;
        const bf16_t* zg = ((bf16_t*)(F.ws + fwo((unsigned)(WS_Z >> 8)))) + (row0 + 32 * qh) * ZLD + F_LG + g * 96 + ch;
#pragma unroll
        for (int tt = 0; tt < 32; ++tt) { wv[tt] = ag[(size_t)tt * W_LRU]; gv[tt] = zg[(size_t)tt * ZLD]; }
        hs = ((float*)(F.ws + fwo((unsigned)(WS_LHS >> 8))))[((size_t)(pb * NCH + pc)) * W_LRU + g * 96 + ch];
        if (qh == 0) { float Pp = 1.f, Hh = 0.f;
#pragma unroll
            for (int tt = 0; tt < 32; ++tt) { const float a = __builtin_amdgcn_exp2f(__builtin_bit_cast(float, wv[tt] << 16)); Hh = a * Hh + __builtin_bit_cast(float, wv[tt] & 0xffff0000u); Pp *= a; }
            PH[ch * 2] = Pp; PH[ch * 2 + 1] = Hh; } }
    hbar(H, lane);
    if (act) { float hc = hs; if (qh == 1) hc = PH[ch * 2] * hc + PH[ch * 2 + 1];
        bf16_t* mo = ((bf16_t*)(F.ws + fwo((unsigned)(WS_MIX >> 8)))) + (row0 + 32 * qh) * D + W_GLA + g * 96 + ch;
#pragma unroll
        for (int tt = 0; tt < 32; ++tt) { hc = __builtin_amdgcn_exp2f(__builtin_bit_cast(float, wv[tt] << 16)) * hc + __builtin_bit_cast(float, wv[tt] & 0xffff0000u); mo[(size_t)tt * D] = f2bf(hc * gelu_t(bf2f(gv[tt]))); }
        if (pc == NCH - 1 && qh == 1) F.out[O_LRU_P + ((size_t)l * BATCH + pb) * W_LRU + g * 96 + ch] = hc; }
    hbar(H, lane);
}

constexpr int U_PG = BATCH * NCH * 4;
constexpr int U_PL = BATCH * NCH * 8;
constexpr int U_SG = DEC_BATCH * 4;
constexpr int U_SL = (MS / 64) * 8;
__device__ __forceinline__ LP make_lp(Frame& F, int l) {
    LP P; P.gwa = INP(I_GWA) + (size_t)l * GLA_RANK * 384; P.gba = INP(I_GBA) + (size_t)l * 384; P.gng = INP(I_GNG) + (size_t)l * W_GLA; P.rng = INP(I_RNG) + (size_t)l * W_RET;
    P.lcw = INP(I_LCW) + (size_t)l * 4 * W_LRU; P.lcb = INP(I_LCB) + (size_t)l * W_LRU; P.lba = INP(I_LBA) + (size_t)l * W_LRU; P.lbx = INP(I_LBX) + (size_t)l * W_LRU;
    P.spl = ((float*)(F.ws + fwo((unsigned)(WS_SPL >> 8)))) + (size_t)l * W_LRU;
    P.sgla = INP(I_SGLA); P.sret = INP(I_SRET); P.slru = INP(I_SLRU) + (size_t)l * DEC_BATCH * W_LRU; P.slconv = INP(I_SLCONV) + (size_t)l * DEC_BATCH * 3 * W_LRU;
    return P;
}
#ifndef UMASK
#define UMASK 0xFF
#endif
#define UM(k) ((F.umask >> (k)) & 1)
#define HUNIT_LOOP(NU_, OFF_, BODY_) do { for (int r = (int)(((unsigned)wk + (unsigned)NW - (unsigned)((OFF_) % NW)) % (unsigned)NW); r < (NU_); r += NW) { BODY_; } } while (0)
__device__ __forceinline__ void phase_ma(Frame& F, Half& H, int l) {
    const LP P = make_lp(F, l); const int NW = 2 * F.G, wk = 2 * (int)blockIdx.x + H.hid;
    if (UM(5)) HUNIT_LOOP(U_PL, 0, (lru_unit<0, false>(F, H, P, l, r >> 3, r & 7)));
    if (UM(0)) HUNIT_LOOP(U_SG, U_PL, mix_sample_unit<0>(F, H, P, l, r >> 2, r & 3));
    if (UM(1)) HUNIT_LOOP(U_SG, U_PL + U_SG, mix_sample_unit<1>(F, H, P, l, r >> 2, r & 3));
    if (UM(3)) HUNIT_LOOP(U_PG, U_PL + 2 * U_SG, (mix_prompt_unit<0, 0>(F, H, P, l, r / (NCH * 4), (r >> 2) % NCH, r & 3)));
    if (UM(4)) HUNIT_LOOP(U_PG, U_PL + 2 * U_SG + U_PG, (mix_prompt_unit<1, 0>(F, H, P, l, r / (NCH * 4), (r >> 2) % NCH, r & 3)));
    if (UM(2)) HUNIT_LOOP(U_SL, U_PL + 2 * U_SG + 2 * U_PG, (lru_unit<1, true>(F, H, P, l, MP / 64 + (r >> 3), r & 7)));
}
__device__ __forceinline__ void phase_mc(Frame& F, Half& H, int l) {
    const LP P = make_lp(F, l); const int NW = 2 * F.G, wk = 2 * (int)blockIdx.x + H.hid;
    if (UM(6)) HUNIT_LOOP(U_PG, 0, (mix_prompt_unit<0, 1>(F, H, P, l, r / (NCH * 4), (r >> 2) % NCH, r & 3)));
    if (UM(7)) HUNIT_LOOP(U_PG, U_PG, (mix_prompt_unit<1, 1>(F, H, P, l, r / (NCH * 4), (r >> 2) % NCH, r & 3)));
    if (UM(2)) HUNIT_LOOP(U_PL, 2 * U_PG, lru_out_unit(F, H, P, l, r >> 3, r & 7));
}
template <int KIND> __device__ __forceinline__ void mb_item(Frame& F, int l, int it) {
    typedef MK<KIND> K; constexpr int DK = K::DK, DV = K::DV, NQ = KIND ? 2 : 1, QPR = DK / (4 * NQ);
    const int dq = it % QPR, j = (it / QPR) % DV, h = (it / (QPR * DV)) % 4, b = it / (QPR * DV * 4); const int d0 = 4 * NQ * dq;
    const bf16_t* DS = KIND ? ((bf16_t*)(F.ws + fwo((unsigned)(WS_DSR >> 8)))) : ((bf16_t*)(F.ws + fwo((unsigned)(WS_DSG >> 8)))); bf16_t* SS = KIND ? ((bf16_t*)(F.ws + fwo((unsigned)(WS_SSR >> 8)))) : ((bf16_t*)(F.ws + fwo((unsigned)(WS_SSG >> 8))));
    f32x4 S[NQ]; f32x4 cdec = {0.f, 0.f, 0.f, 0.f}; if (KIND) { const float e = fexp(64.f * ret_logg(h)); cdec = (f32x4){e, e, e, e}; }
#pragma unroll
    for (int q = 0; q < NQ; ++q) S[q] = (f32x4){0.f, 0.f, 0.f, 0.f};
    const float* DECp = ((float*)(F.ws + fwo((unsigned)(WS_DECG >> 8))));
#pragma unroll 1
    for (int c0 = 0; c0 < NCH; c0 += 16) { u32x2 ds[16][NQ]; f32x4 dc[16];
#pragma unroll
        for (int k = 0; k < 16; ++k) { const size_t ub = (size_t)(b * NCH + c0 + k) * 4 + h; dc[k] = KIND ? cdec : *(const f32x4*)(DECp + ub * DK + d0);
#pragma unroll
            for (int q = 0; q < NQ; ++q) ds[k][q] = __builtin_nontemporal_load((const u32x2*)(DS + ub * (size_t)(DV * DK) + (size_t)j * DK + d0 + 4 * q)); }
#pragma unroll
        for (int k = 0; k < 16; ++k) { const size_t ub = (size_t)(b * NCH + c0 + k) * 4 + h; const size_t e = ub * (size_t)(DV * DK) + (size_t)j * DK + d0;
#pragma unroll
            for (int q = 0; q < NQ; ++q) { *(u32x2*)(SS + e + 4 * q) = (u32x2){cvt_pk(S[q][0], S[q][1]), cvt_pk(S[q][2], S[q][3])};
                const f32x4 dv = {__builtin_bit_cast(float, ds[k][q].x << 16), __builtin_bit_cast(float, ds[k][q].x & 0xffff0000u), __builtin_bit_cast(float, ds[k][q].y << 16), __builtin_bit_cast(float, ds[k][q].y & 0xffff0000u)};
                S[q] = dc[k] * S[q] + dv; } } }
    float* o = F.out + (KIND ? O_RET_P : O_GLA_P) + (((size_t)l * BATCH + b) * 4 + h) * (size_t)(DK * DV) + j;
#pragma unroll
    for (int q = 0; q < NQ; ++q)
#pragma unroll
        for (int i = 0; i < 4; ++i) o[(size_t)(d0 + 4 * q + i) * DV] = S[q][i];
}
__device__ __forceinline__ void phase_mb(Frame& F, int l) {
    constexpr int NG_ = BATCH * 4 * DV_GLA * (DK_GLA / 4), NR_ = BATCH * 4 * DV_RET * (DK_RET / 8), NL_ = BATCH * W_LRU;
    const int gt = (int)blockIdx.x * NTHR + fresh_s(F.wave) * 64 + fresh_lane(), NGT = F.G * NTHR;
    for (int it = gt; it < NG_ + NR_ + NL_; it += NGT) {
        if (it < NG_) mb_item<0>(F, l, it);
        else if (it < NG_ + NR_) mb_item<1>(F, l, it - NG_);
        else { const int r = it - NG_ - NR_, b = r / W_LRU, ch = r % W_LRU; float hc = 0.f;
            const float* lab = ((float*)(F.ws + fwo((unsigned)(WS_LAB >> 8)))); float* lhs = ((float*)(F.ws + fwo((unsigned)(WS_LHS >> 8)))); f32x2 ab[NCH];
#pragma unroll
            for (int c = 0; c < NCH; ++c) ab[c] = *(const f32x2*)(lab + ((size_t)(b * NCH + c) * W_LRU + ch) * 2);
#pragma unroll
            for (int c = 0; c < NCH; ++c) { lhs[(size_t)(b * NCH + c) * W_LRU + ch] = hc; hc = ab[c].x * hc + ab[c].y; } }
    }
}
__device__ __forceinline__ void phase_fx(Frame& F, int l) {
    const int gt = (int)blockIdx.x * NTHR + fresh_s(F.wave) * 64 + fresh_lane(), NGT = F.G * NTHR;
    const float* cw = INP(I_FCW) + (size_t)l * 3 * 2 * D_FF; const float* cb = INP(I_FCB) + (size_t)l * 2 * D_FF;
    for (int it = gt; it < (MP / 256) * (D_FF / 4); it += NGT) { const int pm = it / (D_FF / 4), f = 4 * (it % (D_FF / 4)), pn = f >> 7, cc = f & 127;
        const float* R1 = ((float*)(F.ws + fwo((unsigned)(WS_RAW >> 8)))) + (size_t)pm * 4 * (2 * D_FF) + pn * 256 + cc;
        if ((pm & 7) != 0) { const float* R0 = R1 - 4 * (2 * D_FF);
            f32x4 ug[2], uv[2];
#pragma unroll
            for (int p = 0; p < 2; ++p) { const int col = p * D_FF + f;
                const f32x4 xm2 = *(const f32x4*)(R0 + 2 * (2 * D_FF) + p * 128), xm1 = *(const f32x4*)(R0 + 3 * (2 * D_FF) + p * 128), x0 = *(const f32x4*)(R1 + p * 128), x1 = *(const f32x4*)(R1 + (2 * D_FF) + p * 128);
                const f32x4 w0 = *(const f32x4*)(cw + col), w1 = *(const f32x4*)(cw + 2 * D_FF + col), w2 = *(const f32x4*)(cw + 4 * D_FF + col), bb = *(const f32x4*)(cb + col);
                const f32x4 u0 = w0 * xm2 + w1 * xm1 + w2 * x0 + bb, u1 = w0 * xm1 + w1 * x0 + w2 * x1 + bb;
                if (p == 0) { ug[0] = u0; ug[1] = u1; } else { uv[0] = u0; uv[1] = u1; } }
            bf16_t* hp = ((bf16_t*)(F.ws + fwo((unsigned)(WS_H >> 8)))) + ((size_t)pm * 256) * D_FF + f;
#pragma unroll
            for (int r = 0; r < 2; ++r) *(u32x2*)(hp + (size_t)r * D_FF) = (u32x2){cvt_pk(siluf(ug[r][0]) * uv[r][0], siluf(ug[r][1]) * uv[r][1]), cvt_pk(siluf(ug[r][2]) * uv[r][2], siluf(ug[r][3]) * uv[r][3])}; }
        if ((pm & 7) == 7) { const int b = pm >> 3;
#pragma unroll
            for (int p = 0; p < 2; ++p)
#pragma unroll
                for (int k = 0; k < 2; ++k) *(f32x4*)(F.out + O_FCONV_P + (((size_t)l * BATCH + b) * 2 + k) * (2 * D_FF) + p * D_FF + f) = *(const f32x4*)(R1 + (size_t)(2 + k) * (2 * D_FF) + p * 128); }
    }
    const float* sb = INP(I_SFCONV) + (size_t)l * DEC_BATCH * 2 * 2 * D_FF; const float* RS = ((float*)(F.ws + fwo((unsigned)(WS_RAWS >> 8))));
    for (int it = gt; it < DEC_BATCH * (D_FF / 4); it += NGT) { const int bs = it / (D_FF / 4), f = 4 * (it % (D_FF / 4)); f32x4 ug[2], uv[2];
#pragma unroll
        for (int p = 0; p < 2; ++p) { const int col = p * D_FF + f;
            const f32x4 b0 = *(const f32x4*)(sb + ((size_t)bs * 2 + 0) * (2 * D_FF) + col), b1 = *(const f32x4*)(sb + ((size_t)bs * 2 + 1) * (2 * D_FF) + col), x0 = *(const f32x4*)(RS + ((size_t)bs * 2 + 0) * (2 * D_FF) + col), x1 = *(const f32x4*)(RS + ((size_t)bs * 2 + 1) * (2 * D_FF) + col);
            const f32x4 w0 = *(const f32x4*)(cw + col), w1 = *(const f32x4*)(cw + 2 * D_FF + col), w2 = *(const f32x4*)(cw + 4 * D_FF + col), bb = *(const f32x4*)(cb + col);
            const f32x4 u0 = w0 * b0 + w1 * b1 + w2 * x0 + bb, u1 = w0 * b1 + w1 * x0 + w2 * x1 + bb;
            if (p == 0) { ug[0] = u0; ug[1] = u1; } else { uv[0] = u0; uv[1] = u1; } }
        bf16_t* hp = ((bf16_t*)(F.ws + fwo((unsigned)(WS_H >> 8)))) + ((size_t)MP + 8 * bs) * D_FF + f;
#pragma unroll
        for (int r = 0; r < 2; ++r) *(u32x2*)(hp + (size_t)r * D_FF) = (u32x2){cvt_pk(siluf(ug[r][0]) * uv[r][0], siluf(ug[r][1]) * uv[r][1]), cvt_pk(siluf(ug[r][2]) * uv[r][2], siluf(ug[r][3]) * uv[r][3])}; }
}

constexpr int AD_RSW = 400, AD_RSA = 272, AD_WB = 64 * AD_RSW, AD_AB = 144 * AD_RSA, AD_A0 = 2 * AD_WB;
static_assert(AD_A0 + 2 * AD_AB <= MISC_OFF && 4 * 27 * 64 * 16 <= MISC_OFF, "adaln_direct LDS");
__device__ __forceinline__ void ad_load_w(f32x4 (&r)[6], const float* wp, int ck) {
    const float* q = wp + (size_t)ck * 64 * (6 * D);
#pragma unroll
    for (int p = 0; p < 2; ++p)
#pragma unroll
        for (int i = 0; i < 3; ++i) r[p * 3 + i] = __builtin_nontemporal_load((const f32x4*)(q + (size_t)p * 32 * (6 * D) + 64 * i));
}
__device__ __forceinline__ void ad_write_w(const f32x4 (&r)[6], LAS unsigned char* wl) {
#pragma unroll
    for (int p = 0; p < 2; ++p)
#pragma unroll
        for (int i = 0; i < 3; ++i) *(LAS u32x2*)(wl + p * 32 * AD_RSW + i * 128) = (u32x2){cvt_pk(r[p * 3 + i][0], r[p * 3 + i][1]), cvt_pk(r[p * 3 + i][2], r[p * 3 + i][3])};
}
__device__ __forceinline__ void ad_load_a(u32x4 (&r)[5], const bf16_t* CA, int sa, int tid) {
#pragma unroll
    for (int j = 0; j < 5; ++j) { const int v = tid + 512 * j; r[j] = (u32x4){0u, 0u, 0u, 0u}; if (v < 144 * 16) r[j] = *(const u32x4*)(CA + (size_t)(v >> 4) * D + 128 * sa + 8 * (v & 15)); }
}
__device__ __forceinline__ void ad_write_a(const u32x4 (&r)[5], LAS unsigned char* ab, int tid) {
#pragma unroll
    for (int j = 0; j < 5; ++j) { const int v = tid + 512 * j; if (v < 144 * 16) *(LAS u32x4*)(ab + (v >> 4) * AD_RSA + (v & 15) * 16) = r[j]; }
}
__device__ __forceinline__ void ad_compute(f32x4 (&acc)[9][3], LAS const unsigned char* wb, LAS const unsigned char* ab, int kofs, int kh, int wq, int fr, int fq) {
    bf16x8 b[3];
#pragma unroll
    for (int t = 0; t < 3; ++t) b[t] = tr_frag<AD_RSW>(wb, 32 * kh, 16 * (3 * wq + t), fr, fq);
#pragma unroll
    for (int mt = 0; mt < 9; ++mt) { const bf16x8 a = row_frag(ab, AD_RSA, 16 * mt + fr, kofs + 8 * fq);
#pragma unroll
        for (int t = 0; t < 3; ++t) acc[mt][t] = mma(b[t], a, acc[mt][t]); }
}
__device__ __forceinline__ void adaln_direct(Frame& F) {
    const int lane = fresh_lane(), wave = fresh_s(F.wave), tid = wave * 64 + lane, fr = lane & 15, fq = lane >> 4, kh = wave >> 2, wq = wave & 3;
    const bf16_t* CA = ((bf16_t*)(F.ws + fwo((unsigned)(WS_CACT >> 8)))); float* MOD = ((float*)(F.ws + fwo((unsigned)(WS_MOD >> 8)))); const float* bias = INP(I_BADA);
    LAS unsigned char* lds = F.lds;
    for (int st = (int)blockIdx.x; st < MODLD / 192; st += F.G) {
        const int l = st / (6 * D / 192), n0 = (st % (6 * D / 192)) * 192;
        const float* W = INP(I_WADA) + (size_t)l * D * (6 * D) + n0;
        f32x4 acc[9][3];
#pragma unroll
        for (int mt = 0; mt < 9; ++mt)
#pragma unroll
            for (int t = 0; t < 3; ++t) acc[mt][t] = (f32x4){0.f, 0.f, 0.f, 0.f};
        f32x4 w0[6], w1[6]; u32x4 ar[5];
        const float* wp = W + (size_t)(4 * wave + (lane >> 4)) * (6 * D) + 4 * (lane & 15); LAS unsigned char* wl = lds + (4 * wave + (lane >> 4)) * AD_RSW + (lane & 15) * 8;
        ad_load_a(ar, CA, 0, tid); ad_load_w(w0, wp, 0); ad_load_w(w1, wp, 1);
        ad_write_a(ar, lds + AD_A0, tid); ad_load_a(ar, CA, 1, tid);
#pragma unroll 1
        for (int sa = 0; sa < D / 128; ++sa) {
            LAS unsigned char* ab = lds + AD_A0 + (sa & 1) * AD_AB; LAS unsigned char* abn = lds + AD_A0 + ((sa + 1) & 1) * AD_AB;
            ad_write_w(w0, wl);
            asm volatile("s_waitcnt lgkmcnt(0)" ::: "memory"); __syncthreads();
            ad_load_w(w0, wp, min(2 * sa + 2, D / 64 - 1));
            ad_compute(acc, lds, ab, 32 * kh, kh, wq, fr, fq);
            ad_write_w(w1, wl + AD_WB); ad_write_a(ar, abn, tid);
            asm volatile("s_waitcnt lgkmcnt(0)" ::: "memory"); __syncthreads();
            ad_load_w(w1, wp, min(2 * sa + 3, D / 64 - 1)); ad_load_a(ar, CA, min(sa + 2, D / 128 - 1), tid);
            ad_compute(acc, lds + AD_WB, ab, 64 + 32 * kh, kh, wq, fr, fq);
        }
        __syncthreads();
        if (kh == 1) {
#pragma unroll
            for (int mt = 0; mt < 9; ++mt)
#pragma unroll
                for (int t = 0; t < 3; ++t) *(LAS f32x4*)(lds + (size_t)(((wq * 27 + mt * 3 + t) * 64 + lane) * 16)) = acc[mt][t]; }
        asm volatile("s_waitcnt lgkmcnt(0)" ::: "memory"); __syncthreads();
        if (kh == 0) {
#pragma unroll
            for (int t = 0; t < 3; ++t) { const int col = l * 6 * D + n0 + 16 * (3 * wq + t) + 4 * fq; const f32x4 bb = *(const f32x4*)(bias + col);
#pragma unroll
                for (int mt = 0; mt < 9; ++mt) { const int m = 16 * mt + fr; const f32x4 o = acc[mt][t] + *(const LAS f32x4*)(lds + (size_t)(((wq * 27 + mt * 3 + t) * 64 + lane) * 16)) + bb;
                    if (m < NSEQ) *(f32x4*)(MOD + (size_t)m * MODLD + col) = o; } } }
        __syncthreads();
    }
}

struct Args { const float* in[N_INPUTS]; float* out; unsigned char* ws; int ph_lo, ph_hi, umask, pad; };
#ifndef G2_SPLIT
#define G2_SPLIT 4
#endif
#ifndef G4_SPLIT
#define G4_SPLIT 4
#endif
#ifndef DBG_KEEPNORM
#define DBG_KEEPNORM 0
#endif
#ifndef WGM_G1
#define WGM_G1 12
#endif
#ifndef WGM_G3
#define WGM_G3 12
#endif
constexpr int CW_PAN = 16384;
constexpr int PH_PER_LAYER = 10, PH_TOTAL = 2 + DEPTH * PH_PER_LAYER + 1;
__global__ void __launch_bounds__(NTHR, 2) mega(Args args) {
    extern __shared__ __attribute__((aligned(16))) unsigned char lds[];
    Frame F;
    F.lds = (LAS unsigned char*)lds; F.MISC = (volatile LAS unsigned*)(F.lds + MISC_OFF);
    F.wave = __builtin_amdgcn_readfirstlane((int)threadIdx.x >> 6); asm volatile("" : "+s"(F.wave)); F.G = gridDim.x; F.gw = (int)blockIdx.x * NWAVES + F.wave; F.NGW = F.G * NWAVES;
    F.inp = args.in; F.umask = args.umask;
    F.out = args.out; unsigned char* ws = args.ws; F.ws = ws;
    if (threadIdx.x < 64) F.MISC[threadIdx.x] = 0u;
    Half H; H.hid = F.wave >> 2; H.lds = F.lds + H.hid * HALF_LDS; H.cnt = (LAS unsigned*)(F.lds + MISC_OFF) + 16 + 16 * H.hid; H.tgt = 0u;
    __syncthreads();
    const int lo = args.ph_lo, hi = args.ph_hi;
    const bool one = (hi - lo) > 1;
    XcdBarrier bar; bar.bar = (unsigned*)(ws + WS_CTL) + CW_BAR; bar.x = 0; bar.st = nullptr;
    if (one) bar = xcd_barrier_post((unsigned*)(ws + WS_CTL) + CW_BAR, F.MISC + 8, threadIdx.x == 0);
#ifndef PMASK
#define PMASK 0xFFFF
#endif
#define PM(k) (((PMASK) >> (k)) & 1)
#ifndef DUPMASK
#define DUPMASK 0
#endif
#define REP(k) _Pragma("unroll 1") for (int rep_ = 0; rep_ < 1 + (((DUPMASK) >> (k)) & 1); ++rep_)
#define IN(k) (lo <= (k) && (k) < hi)
#define SEAM(k) do { if (IN(k) && IN((k) + 1)) xcd_barrier(bar, F.wave == 0 && fresh_lane() == 0); } while (0)
    if (PM(0) && IN(0)) REP(0) { p0_prologue(F); } SEAM(0);
#if ADA_DIRECT
    if (PM(1) && IN(1)) REP(1) adaln_direct(F);
#else
    if (PM(1) && IN(1)) REP(1) { pg8::Gemm g{((bf16_t*)(F.ws + fwo((unsigned)(WS_CACT >> 8)))), ((bf16_t*)(F.ws + fwo((unsigned)(WS_WADA >> 8)))), 256, MODLD, D, D}; pg8::StaticOrder S; S.init(256, MODLD, F.G, (int)blockIdx.x, D / 64); EpiMod E{((float*)(F.ws + fwo((unsigned)(WS_MOD >> 8)))), INP(I_BADA)};
        pg8::gemm_phase<EpiMod, pg8::StaticOrder, true, true>(F.lds, g, S, E, F.wave); }
#endif
    SEAM(1);
    constexpr int fusedn = 0;
#pragma unroll 1
    for (int l = 0; l < DEPTH; ++l) {
        const int p0 = 2 + l * PH_PER_LAYER; const int mo = l * 6 * D;
        if (l == 0 || !fusedn || DBG_KEEPNORM) { if (PM(2) && IN(p0 + 0)) REP(2) norm_phase(F, INP(I_N1G) + l * D, mo + 0 * D, mo + 1 * D, l > 0, l == 0 ? INP(I_XP) : nullptr, l == 0 ? INP(I_XS) : nullptr); SEAM(p0 + 0); }
        if (PM(3) && IN(p0 + 1)) REP(3) { pg8::Gemm g{((bf16_t*)(F.ws + fwo((unsigned)(WS_HN >> 8)))), ((bf16_t*)(F.ws + fwo((unsigned)(WS_WIN >> 8)))) + (size_t)l * ZLD * D, M, ZLD, D, D}; pg8::StaticOrder S; S.init(M, ZLD, F.G, (int)blockIdx.x, D / 64, 1, 0, WGM_G1); EpiZ E{((bf16_t*)(F.ws + fwo((unsigned)(WS_Z >> 8)))), ZLD};
            pg8::gemm_phase<EpiZ, pg8::StaticOrder, true, true>(F.lds, g, S, E, F.wave); steal_transposes(F, qcap(l, 28, I_IN + I_OUT)); } SEAM(p0 + 1);
        if (PM(4) && IN(p0 + 2)) REP(4) phase_ma(F, H, l); SEAM(p0 + 2);
        if (PM(5) && IN(p0 + 3)) REP(5) phase_mb(F, l); SEAM(p0 + 3);
        if (PM(6) && IN(p0 + 4)) REP(6) phase_mc(F, H, l); SEAM(p0 + 4);
        if (PM(7) && IN(p0 + 5)) { pg8::Gemm g{((bf16_t*)(F.ws + fwo((unsigned)(WS_MIX >> 8)))), ((bf16_t*)(F.ws + fwo((unsigned)(WS_WOUT >> 8)))) + (size_t)l * D * D, M, D, D, D}; ResOrder S{F.G, (int)blockIdx.x, D / 64, D / SPLIT}; EpiResGate E{((float*)(F.ws + fwo((unsigned)(WS_X >> 8)))), ((float*)(F.ws + fwo((unsigned)(WS_MOD >> 8)))), ((float*)(F.ws + fwo((unsigned)(WS_PART >> 8)))), mo + 2 * D, D / SPLIT, (F.umask & 0x100) ? (float*)(F.ws + fwo((unsigned)(WS_Z >> 8))) : nullptr, l == 0 ? INP(I_XP) : nullptr, l == 0 ? INP(I_XS) : nullptr,
                NormP{INP(I_N2G) + l * D, ((float*)(F.ws + fwo((unsigned)(WS_MOD >> 8)))), mo + 3 * D, mo + 4 * D, ((bf16_t*)(F.ws + fwo((unsigned)(WS_HN >> 8)))), nullptr, ((float*)(F.ws + fwo((unsigned)(WS_PART >> 8)))), (unsigned*)(F.ws + WS_CTL) + CW_PAN + ((l * 2 + 0) * 36) * 64, (unsigned*)(F.ws + WS_CTL) + 2, (LAS unsigned*)(F.lds + HALO_OFF), fusedn}};
            pg8::gemm_phase<EpiResGate, ResOrder, true, true>(F.lds, g, S, E, F.wave); steal_transposes(F, qcap(l, 35, I_IN + I_OUT + I_UP)); } SEAM(p0 + 5);
        if (!fusedn || DBG_KEEPNORM) { if (PM(2) && IN(p0 + 6)) REP(2) norm_phase(F, INP(I_N2G) + l * D, mo + 3 * D, mo + 4 * D, true, nullptr, nullptr); SEAM(p0 + 6); }
        if (PM(9) && IN(p0 + 7)) REP(9) { pg8::Gemm g{((bf16_t*)(F.ws + fwo((unsigned)(WS_HN >> 8)))), ((bf16_t*)(F.ws + fwo((unsigned)(WS_WUP >> 8)))) + (size_t)l * 2 * D_FF * D, M, 2 * D_FF, D, D}; pg8::StaticOrder S; S.init(M, 2 * D_FF, F.G, (int)blockIdx.x, D / 64, 1, 0, WGM_G3);
            EpiConvFfn E{((bf16_t*)(F.ws + fwo((unsigned)(WS_H >> 8)))), ((float*)(F.ws + fwo((unsigned)(WS_RAW >> 8)))), INP(I_FCW) + (size_t)l * 3 * 2 * D_FF, INP(I_FCB) + (size_t)l * 2 * D_FF, ((float*)(F.ws + fwo((unsigned)(WS_RAWS >> 8)))), F.out + O_FCONV_S + (size_t)l * DEC_BATCH * 2 * 2 * D_FF, (LAS float*)(F.lds + HALO_OFF), (F.umask & 0x800) ? 1 : 0};
            pg8::gemm_phase<EpiConvFfn, pg8::StaticOrder, true, true>(F.lds, g, S, E, F.wave); steal_transposes(F, qcap(l, 82, PER_L4)); } SEAM(p0 + 7);
        if (PM(10) && IN(p0 + 8)) REP(10) phase_fx(F, l); SEAM(p0 + 8);
        if (PM(11) && IN(p0 + 9)) { pg8::Gemm g{((bf16_t*)(F.ws + fwo((unsigned)(WS_H >> 8)))), ((bf16_t*)(F.ws + fwo((unsigned)(WS_WDOWN >> 8)))) + (size_t)l * D * D_FF, M, D, D_FF, D_FF}; ResOrder S{F.G, (int)blockIdx.x, D_FF / 64, D_FF / SPLIT}; EpiResGate E{((float*)(F.ws + fwo((unsigned)(WS_X >> 8)))), ((float*)(F.ws + fwo((unsigned)(WS_MOD >> 8)))), ((float*)(F.ws + fwo((unsigned)(WS_PART >> 8)))), mo + 5 * D, D_FF / SPLIT, (F.umask & 0x100) ? (float*)(F.ws + fwo((unsigned)(WS_Z >> 8))) : nullptr, nullptr, nullptr,
                NormP{l + 1 < DEPTH ? INP(I_N1G) + (l + 1) * D : INP(I_FG), ((float*)(F.ws + fwo((unsigned)(WS_MOD >> 8)))), l + 1 < DEPTH ? mo + 6 * D : -1, mo + 7 * D, ((bf16_t*)(F.ws + fwo((unsigned)(WS_HN >> 8)))), F.out + O_YP, ((float*)(F.ws + fwo((unsigned)(WS_PART >> 8)))), (unsigned*)(F.ws + WS_CTL) + CW_PAN + ((l * 2 + 1) * 36) * 64, (unsigned*)(F.ws + WS_CTL) + 2, (LAS unsigned*)(F.lds + HALO_OFF), fusedn}};
            pg8::gemm_phase<EpiResGate, ResOrder, true, true>(F.lds, g, S, E, F.wave); steal_transposes(F, qcap(l, 100, PER_L4 + I_IN)); } SEAM(p0 + 9);
    }
    if (!fusedn || DBG_KEEPNORM) { if (PM(12) && IN(PH_TOTAL - 1)) REP(12) final_norm_phase(F); }
#undef IN
#undef SEAM
}

#ifndef HDUPMASK
#define HDUPMASK 0
#endif
#ifndef HDUPUNITS
#define HDUPUNITS 0xFF
#endif
static void run(void* const* d_in, float* out, void* d_ws, size_t ws_size, hipStream_t stream, int multi) {
    static int grid = 0;
    if (grid == 0) {
        int dev = 0, cus = 0, per_cu = 0;
        if (ws_size < WS_END) { fprintf(stderr, "kernel_launch: workspace too small: %zu < %zu\n", ws_size, (size_t)WS_END); grid = -1; return; }
        if (hipGetDevice(&dev) != hipSuccess || hipDeviceGetAttribute(&cus, hipDeviceAttributeMultiprocessorCount, dev) != hipSuccess) { grid = -1; return; }
        if (hipFuncSetAttribute((const void*)mega, hipFuncAttributeMaxDynamicSharedMemorySize, LDS_BYTES) != hipSuccess) { fprintf(stderr, "kernel_launch: hipFuncSetAttribute failed\n"); grid = -1; return; }
        if (hipOccupancyMaxActiveBlocksPerMultiprocessor(&per_cu, (const void*)mega, NTHR, LDS_BYTES) != hipSuccess || per_cu < 1) { fprintf(stderr, "kernel_launch: occupancy query says %d blocks/CU\n", per_cu); (void)hipGetLastError(); grid = -1; return; }
        grid = cus;
    }
    if (grid < 0) return;
    (void)hipMemsetAsync((char*)d_ws + WS_CTL, 0, CTL_ZERO_BYTES, stream);
    Args a{}; for (int i = 0; i < N_INPUTS; ++i) a.in[i] = (const float*)d_in[i];
    a.out = out; a.ws = (unsigned char*)d_ws; a.umask = 0xFF;
    if (!multi) { a.ph_lo = 0; a.ph_hi = PH_TOTAL; hipLaunchKernelGGL(mega, dim3(grid), dim3(NTHR), LDS_BYTES, stream, a); }
    else for (int p = 0; p < PH_TOTAL; ++p) { a.ph_lo = p; a.ph_hi = p + 1; hipLaunchKernelGGL(mega, dim3(grid), dim3(NTHR), LDS_BYTES, stream, a);
        static const int tmap[10] = {2, 3, 4, 5, 6, 7, 2, 9, 10, 11}; const int ty = p == 0 ? 0 : (p == 1 ? 1 : (p == PH_TOTAL - 1 ? 12 : tmap[(p - 2) % 10]));
        if ((HDUPMASK >> ty) & 1) { a.umask = HDUPUNITS; hipLaunchKernelGGL(mega, dim3(grid), dim3(NTHR), LDS_BYTES, stream, a); a.umask = 0xFF; hipLaunchKernelGGL(mega, dim3(grid), dim3(NTHR), LDS_BYTES, stream, a); } }
}
}
#ifndef FK_MULTI
#define FK_MULTI 0
#endif
extern "C" void kernel_launch(void* const* d_in, const int* in_sizes, int n_in, void* d_out, int out_size, void* d_ws, size_t ws_size, hipStream_t stream) {
    if (n_in != cfg::N_INPUTS || (size_t)out_size != cfg::O_END) { fprintf(stderr, "kernel_launch: unexpected n_in %d / out_size %d\n", n_in, out_size); return; }
    fk::run(d_in, (float*)d_out, d_ws, ws_size, stream, FK_MULTI);
}
```

```cpp
#include <hip/hip_runtime.h>
#include <cstdio>
#include <cstdint>
#include <cmath>
namespace cfg {
constexpr int D = 2048, BATCH = 4, SEQ = 2048, DEPTH = 4, DEC_BATCH = 128, DEC_SEQ = 8, PAST = 16384;
constexpr int W_GLA = 768, W_LRU = 768, W_RET = 512;
constexpr int H_GLA = 4, DV_GLA = 192, DK_GLA = 96, GLA_RANK = 16;
constexpr int H_LRU = 8, BLK_LRU = 96;
constexpr float LRU_C = 8.0f;
constexpr int H_RET = 4, DK_RET = 128, DV_RET = 128;
constexpr int D_FF = 5632;
constexpr int N_IN = 5904;
constexpr int MP = BATCH * SEQ, MS = DEC_BATCH * DEC_SEQ, M = MP + MS, NSEQ = BATCH + DEC_BATCH;
constexpr int Z_GQ = 0, Z_GK = 384, Z_GV = 768, Z_GLR = 1536, Z_GG = 1552, Z_LX = 2320, Z_LG = 3088, Z_RQ = 3856, Z_RK = 4368, Z_RV = 4880, Z_RG = 5392;
enum { I_XP = 0, I_XS, I_SGLA, I_SRET, I_SLRU, I_SLCONV, I_SFCONV, I_CP, I_CS, I_N1G, I_N2G, I_FG, I_WADA, I_BADA, I_WIN, I_GWA, I_GBA, I_GNG, I_LCW, I_LCB, I_LWA, I_LBA, I_LWX, I_LBX, I_LLAM, I_RNG, I_WOUT, I_WUP, I_FCW, I_FCB, I_WDOWN, N_INPUTS };
constexpr size_t O_YP = 0;
constexpr size_t O_YS = O_YP + (size_t)MP * D;
constexpr size_t O_GLA_P = O_YS + (size_t)MS * D;
constexpr size_t O_RET_P = O_GLA_P + (size_t)DEPTH * BATCH * H_GLA * DK_GLA * DV_GLA;
constexpr size_t O_LRU_P = O_RET_P + (size_t)DEPTH * BATCH * H_RET * DK_RET * DV_RET;
constexpr size_t O_LCONV_P = O_LRU_P + (size_t)DEPTH * BATCH * W_LRU;
constexpr size_t O_FCONV_P = O_LCONV_P + (size_t)DEPTH * BATCH * 3 * W_LRU;
constexpr size_t O_GLA_S = O_FCONV_P + (size_t)DEPTH * BATCH * 2 * 2 * D_FF;
constexpr size_t O_RET_S = O_GLA_S + (size_t)DEPTH * DEC_BATCH * H_GLA * DK_GLA * DV_GLA;
constexpr size_t O_LRU_S = O_RET_S + (size_t)DEPTH * DEC_BATCH * H_RET * DK_RET * DV_RET;
constexpr size_t O_LCONV_S = O_LRU_S + (size_t)DEPTH * DEC_BATCH * W_LRU;
constexpr size_t O_FCONV_S = O_LCONV_S + (size_t)DEPTH * DEC_BATCH * 3 * W_LRU;
constexpr size_t O_END = O_FCONV_S + (size_t)DEPTH * DEC_BATCH * 2 * 2 * D_FF;
}
__device__ __forceinline__ int fresh_lane() { unsigned m = ~0u; asm volatile("" : "+s"(m)); return (int)__builtin_amdgcn_mbcnt_hi(m, __builtin_amdgcn_mbcnt_lo(m, 0u)); }
__device__ __forceinline__ int fresh_s(int v) { asm volatile("" : "+s"(v)); return v; }
#define FK_MULTI 0
#define HDUPMASK 0
#define HDUPUNITS 0xFF
namespace pg8 {
#define PG8_LAS __attribute__((address_space(3)))
typedef unsigned short bf16_t;
typedef short bf16x8 __attribute__((ext_vector_type(8)));
typedef float f32x4 __attribute__((ext_vector_type(4)));
typedef unsigned u32x4 __attribute__((ext_vector_type(4)));
constexpr int BM = 256, BK = 64, HALF = 128, HTB = HALF * BK * 2  , STAGE_BYTES = 8 * HTB, NXCD = 8, WGM = 12;

__host__ __device__ __forceinline__ int lds_byte(int r, int c) { const int st = (r >> 4) * 2 + (c >> 5), rr = r & 15, cc = c & 31, ob = rr * 64 + cc * 2; return st * 1024 + (ob ^ (((ob >> 9) & 1) << 5)); }
__host__ __device__ __forceinline__ void stage_rc(int b, int& R, int& C) { const int st = b / 1024, sb = b % 1024, swz = sb ^ (((sb >> 9) & 1) << 5); R = (st >> 1) * 16 + swz / 64; C = (st & 1) * 32 + (swz % 64) / 2; }
__host__ __device__ __forceinline__ int perm32(int rho) { const int n = rho >> 4, i = rho & 15; return 8 * (i >> 2) + 4 * n + (i & 3); }

struct Unit { int pm, pn, kb, nt; };
struct Gemm { const bf16_t* A; const bf16_t* Bt; int M, N, K, ldk; };

struct StaticOrder {
    int nM, nN, nwg, G, c, S, Ks, ntu, wgm;
    __host__ __device__ void init(int M, int N, int G_, int c_, int ntu_, int S_ = 1, int Ks_ = 0, int wgm_ = WGM) { nM = M / BM; nN = N / BM; nwg = nM * nN; G = G_; c = c_; ntu = ntu_; S = S_; Ks = Ks_; wgm = wgm_; }
    __host__ __device__ bool next(int i, Unit& u) const {
        const long L = (long)i * G + c; if (L >= (long)nwg * S) return false;
        int wgid = (int)(L / S); u.kb = (int)(L % S) * Ks; u.nt = ntu; { const int q = nwg / NXCD, r = nwg % NXCD, xcd = wgid % NXCD, off = wgid / NXCD; wgid = (xcd < r ? xcd * (q + 1) : r * (q + 1) + (xcd - r) * q) + off; }
        const int nig = wgm * nN, gid = wgid / nig, fm = gid * wgm, gsz = (nM - fm) < wgm ? (nM - fm) : wgm;
        u.pm = fm + ((wgid % nig) % gsz); u.pn = (wgid % nig) / gsz; return true;
    }
    __device__ __forceinline__ void a_ready(const Unit&) const {}
    __device__ __forceinline__ void done(const Unit&) const {}
};

__device__ __forceinline__ unsigned cvt_pk_bf16(float lo, float hi) { unsigned r; asm volatile("v_cvt_pk_bf16_f32 %0, %1, %2" : "=v"(r) : "v"(lo), "v"(hi)); return r; }
typedef float f32x2 __attribute__((ext_vector_type(2)));
template <class Epi, class Sched, bool ALIGN_EPI = false, bool SP2 = false>
__device__ __forceinline__ void gemm_phase(PG8_LAS unsigned char* lds, const Gemm g, const Sched& S, const Epi& E, const int wave_id) {
    const int lane = fresh_lane(), wid = fresh_s(wave_id), tid = wid * 64 + lane, wr = wid >> 2, wc = wid & 3, fr = lane & 15, fq = lane >> 4;
    const int K = g.ldk;
    unsigned voffA[2], voffB[2];
#pragma unroll
    for (int i = 0; i < 2; ++i) { int R, C; stage_rc(tid * 16 + i * 8192, R, C); const int Rb = Epi::PERM ? ((R & ~31) + perm32(R & 31)) : R;
        voffA[i] = (unsigned)(R * K + C) * 2u; voffB[i] = (unsigned)(Rb * K + C) * 2u; }
    const size_t kstep = (size_t)(BK * 2);
    const size_t hstep = (size_t)HALF * K * 2;
    const size_t tstep = 2 * hstep;
    const unsigned ldsw = (unsigned)wid * 1024u;
    const int aoff = lds_byte(wr * 64 + fr, fq * 8), boff = lds_byte(wc * 32 + fr, fq * 8);
#define PG8_SA(b, h) (((b) * 2 + (h)) * HTB)
#define PG8_SB(b, h) ((4 + (b) * 2 + (h)) * HTB)
#define PG8_STAGE(bufoff, gbase, voff) do { _Pragma("unroll") for (int _i = 0; _i < 2; ++_i) \
        __builtin_amdgcn_global_load_lds((const unsigned*)((const char*)(gbase) + (voff)[_i]), (PG8_LAS unsigned*)(lds + (bufoff) + ldsw + _i * 8192), 16, 0, 0); } while (0)
#define PG8_LDA(dst, b, h) do { _Pragma("unroll") for (int m = 0; m < 4; ++m) _Pragma("unroll") for (int k = 0; k < 2; ++k) dst[m][k] = *(const PG8_LAS bf16x8*)(lds + PG8_SA(b, h) + aoff + m * 2048 + k * 1024); } while (0)
#define PG8_LDB(dst, b, h) do { _Pragma("unroll") for (int n = 0; n < 2; ++n) _Pragma("unroll") for (int k = 0; k < 2; ++k) dst[n][k] = *(const PG8_LAS bf16x8*)(lds + PG8_SB(b, h) + boff + n * 2048 + k * 1024); } while (0)
#define PG8_MMA(ai, bj, At, Bt) do { __builtin_amdgcn_s_setprio(1); _Pragma("unroll") for (int m = 0; m < 4; ++m) _Pragma("unroll") for (int n = 0; n < 2; ++n) _Pragma("unroll") for (int k = 0; k < 2; ++k) \
        acc[ai][bj][m][n] = __builtin_amdgcn_mfma_f32_16x16x32_bf16(Bt[n][k], At[m][k], acc[ai][bj][m][n], 0, 0, 0); __builtin_amdgcn_s_setprio(0); } while (0)
#define PG8_WAIT_V(n) asm volatile("s_waitcnt vmcnt(" #n ")" ::: "memory")
#define PG8_WAIT_L(n) asm volatile("s_waitcnt lgkmcnt(" #n ")" ::: "memory")
#define PG8_BAR __builtin_amdgcn_s_barrier()
#define PG8_SCHED __builtin_amdgcn_sched_barrier(0)
    Unit cur, nxt; int ui = 0;
    if (!S.next(0, cur)) return;
    f32x4 acc[2][2][4][2];
#pragma unroll
    for (int a = 0; a < 2; ++a)
#pragma unroll
        for (int b = 0; b < 2; ++b)
#pragma unroll
            for (int m = 0; m < 4; ++m)
#pragma unroll
                for (int n = 0; n < 2; ++n) acc[a][b][m][n] = (f32x4){0.f, 0.f, 0.f, 0.f};
    bf16x8 At[4][2], B0[2][2], B1[2][2];
    const char* cA = (const char*)g.A + (size_t)cur.pm * tstep + (size_t)cur.kb * 2; const char* cB = (const char*)g.Bt + (size_t)cur.pn * tstep + (size_t)cur.kb * 2;
    S.a_ready(cur);
    if constexpr (SP2) {
        PG8_STAGE(PG8_SB(0, 0), cB, voffB); PG8_STAGE(PG8_SB(0, 1), cB + hstep, voffB); PG8_STAGE(PG8_SA(0, 0), cA, voffA); PG8_STAGE(PG8_SA(0, 1), cA + hstep, voffA);
        if (wr == 1) PG8_BAR;
        PG8_WAIT_V(2); PG8_BAR;
        PG8_STAGE(PG8_SB(1, 0), cB + kstep, voffB); PG8_STAGE(PG8_SA(1, 0), cA + kstep, voffA); PG8_STAGE(PG8_SB(1, 1), cB + hstep + kstep, voffB);
        PG8_WAIT_V(6); PG8_BAR;
    } else {
        PG8_STAGE(PG8_SB(0, 0), cB, voffB); PG8_STAGE(PG8_SA(0, 0), cA, voffA); PG8_STAGE(PG8_SB(0, 1), cB + hstep, voffB); PG8_STAGE(PG8_SA(0, 1), cA + hstep, voffA);
        if (wr == 1) PG8_BAR;
        PG8_WAIT_V(4); PG8_BAR;
        PG8_STAGE(PG8_SB(1, 0), cB + kstep, voffB); PG8_STAGE(PG8_SA(1, 0), cA + kstep, voffA); PG8_STAGE(PG8_SB(1, 1), cB + hstep + kstep, voffB);
        PG8_WAIT_V(6); PG8_BAR;
    }
    for (;;) {
        const bool has_next = S.next(ui + 1, nxt);
        const char* nA = has_next ? (const char*)g.A + (size_t)nxt.pm * tstep + (size_t)nxt.kb * 2 : cA; const char* nB = has_next ? (const char*)g.Bt + (size_t)nxt.pn * tstep + (size_t)nxt.kb * 2 : cB;
        const int nt = cur.nt;
        for (int t = 0; t < nt; t += 2) {
            const bool last = (t == nt - 2);
            const char* a1 = cA + (size_t)(t + 1) * kstep;
            const char* a2 = last ? nA : cA + (size_t)(t + 2) * kstep; const char* b2 = last ? nB : cB + (size_t)(t + 2) * kstep;
            const char* a3 = a2 + kstep; const char* b3 = b2 + kstep;
            if (last && has_next) S.a_ready(nxt);
            if constexpr (SP2) {
            PG8_LDB(B0, 0, 0); PG8_LDB(B1, 0, 1); PG8_SCHED; PG8_LDA(At, 0, 0); PG8_STAGE(PG8_SA(1, 1), a1 + hstep, voffA);
            PG8_WAIT_V(8); PG8_WAIT_L(0); PG8_BAR; PG8_MMA(0, 0, At, B0); PG8_MMA(0, 1, At, B1); PG8_BAR; PG8_SCHED;
            PG8_LDA(At, 0, 1); PG8_STAGE(PG8_SB(0, 0), b2, voffB); PG8_STAGE(PG8_SB(0, 1), b2 + hstep, voffB); PG8_STAGE(PG8_SA(0, 0), a2, voffA);
            PG8_WAIT_V(8); PG8_WAIT_L(0); PG8_BAR; PG8_MMA(1, 0, At, B0); PG8_MMA(1, 1, At, B1); PG8_BAR; PG8_SCHED;
            PG8_LDB(B0, 1, 0); PG8_LDB(B1, 1, 1); PG8_SCHED; PG8_LDA(At, 1, 0); PG8_STAGE(PG8_SA(0, 1), a2 + hstep, voffA);
            PG8_WAIT_V(8); PG8_WAIT_L(0); PG8_BAR; PG8_MMA(0, 0, At, B0); PG8_MMA(0, 1, At, B1); PG8_BAR; PG8_SCHED;
            PG8_LDA(At, 1, 1); PG8_STAGE(PG8_SB(1, 0), b3, voffB); PG8_STAGE(PG8_SB(1, 1), b3 + hstep, voffB); PG8_STAGE(PG8_SA(1, 0), a3, voffA);
            PG8_WAIT_V(8); PG8_WAIT_L(0); PG8_BAR; PG8_MMA(1, 0, At, B0); PG8_MMA(1, 1, At, B1); PG8_BAR; PG8_SCHED;
            } else {
            PG8_LDB(B0, 0, 0); PG8_SCHED; PG8_LDA(At, 0, 0); PG8_STAGE(PG8_SA(1, 1), a1 + hstep, voffA);
            PG8_WAIT_L(8); PG8_BAR; PG8_WAIT_L(0); PG8_MMA(0, 0, At, B0); PG8_BAR; PG8_SCHED;
            PG8_LDB(B1, 0, 1); PG8_STAGE(PG8_SB(0, 0), b2, voffB);
            PG8_BAR; PG8_WAIT_L(0); PG8_MMA(0, 1, At, B1); PG8_BAR;
            PG8_LDA(At, 0, 1); PG8_STAGE(PG8_SA(0, 0), a2, voffA);
            PG8_BAR; PG8_WAIT_L(0); PG8_MMA(1, 0, At, B0); PG8_BAR; PG8_SCHED;
            PG8_STAGE(PG8_SB(0, 1), b2 + hstep, voffB);
            PG8_WAIT_V(6); PG8_BAR; PG8_MMA(1, 1, At, B1); PG8_BAR;
            PG8_LDB(B0, 1, 0); PG8_SCHED; PG8_LDA(At, 1, 0); PG8_STAGE(PG8_SA(0, 1), a2 + hstep, voffA);
            PG8_WAIT_L(8); PG8_BAR; PG8_WAIT_L(0); PG8_MMA(0, 0, At, B0); PG8_BAR; PG8_SCHED;
            PG8_LDB(B1, 1, 1); PG8_STAGE(PG8_SB(1, 0), b3, voffB);
            PG8_BAR; PG8_WAIT_L(0); PG8_MMA(0, 1, At, B1); PG8_BAR;
            PG8_LDA(At, 1, 1); PG8_STAGE(PG8_SA(1, 0), a3, voffA);
            PG8_BAR; PG8_WAIT_L(0); PG8_MMA(1, 0, At, B0); PG8_BAR; PG8_SCHED;
            PG8_STAGE(PG8_SB(1, 1), b3 + hstep, voffB);
            PG8_WAIT_V(6); PG8_BAR; PG8_MMA(1, 1, At, B1); PG8_BAR;
            }
        }
        if constexpr (ALIGN_EPI) { if (wr == 0) PG8_BAR; }
        if constexpr (!Epi::AFTER_DRAIN) { E(acc, cur, wr, wc, fr, fq); S.done(cur); }
        if (!has_next) break;
#pragma unroll
        for (int a = 0; a < 2; ++a)
#pragma unroll
            for (int b = 0; b < 2; ++b)
#pragma unroll
                for (int m = 0; m < 4; ++m)
#pragma unroll
                    for (int n = 0; n < 2; ++n) acc[a][b][m][n] = (f32x4){0.f, 0.f, 0.f, 0.f};
        cur = nxt; cA = nA; cB = nB; ++ui;
        if constexpr (ALIGN_EPI) { if (wr == 1) PG8_BAR; }
    }
    PG8_WAIT_V(0);
    if constexpr (!ALIGN_EPI) { if (wr == 0) PG8_BAR; }
    PG8_BAR;
    if constexpr (Epi::AFTER_DRAIN) { E.fused(acc, cur, wr, wc, fr, fq, lds, wid, lane); S.done(cur); }
#undef PG8_SA
#undef PG8_SB
#undef PG8_STAGE
#undef PG8_LDA
#undef PG8_LDB
#undef PG8_MMA
#undef PG8_WAIT_V
#undef PG8_WAIT_L
#undef PG8_BAR
#undef PG8_SCHED
}
}
namespace fk {
using namespace cfg;
using pg8::bf16_t; using pg8::bf16x8; using pg8::f32x4; using pg8::u32x4;
#define LAS __attribute__((address_space(3)))
#define GAS __attribute__((address_space(1)))
typedef unsigned u32x2 __attribute__((ext_vector_type(2)));
typedef float f32x2 __attribute__((ext_vector_type(2)));
typedef short s16x4 __attribute__((ext_vector_type(4)));
constexpr int NWAVES = 8, NTHR = 512;
#ifndef ADA_DIRECT
#define ADA_DIRECT 1
#endif
constexpr int SPLIT = 4;
constexpr int ZLD = 6144;
constexpr int F_GQ = 0, F_GK = 384, F_GV = 768, F_GG = 1536, F_LX = 2304, F_LG = 3072, F_RQ = 3840, F_RK = 4352, F_RV = 4864, F_RG = 5376, F_GLR = 5888;
constexpr int NCH = SEQ / 64;
constexpr int MODLD = DEPTH * 6 * D;
constexpr int NPOS = SEQ + DEC_SEQ;
constexpr size_t al(size_t x) { return (x + 4095) / 4096 * 4096; }
constexpr size_t WS_CTL = 0, CTL_ZERO_BYTES = 1u << 20;
constexpr size_t WS_WIN = al(WS_CTL + CTL_ZERO_BYTES);
constexpr size_t WS_WOUT = al(WS_WIN + (size_t)DEPTH * ZLD * D * 2);
constexpr size_t WS_WUP = al(WS_WOUT + (size_t)DEPTH * D * D * 2);
constexpr size_t WS_WDOWN = al(WS_WUP + (size_t)DEPTH * 2 * D_FF * D * 2);
constexpr size_t WS_WADA = al(WS_WDOWN + (size_t)DEPTH * D * D_FF * 2);
constexpr size_t WS_LRUW = al(WS_WADA + (size_t)MODLD * D * 2);
constexpr size_t WS_CACT = al(WS_LRUW + (size_t)DEPTH * 2 * 8 * 96 * 96 * 2);
constexpr size_t WS_MOD = al(WS_CACT + (size_t)256 * D * 2);
constexpr size_t WS_ROPE = al(WS_MOD + (size_t)256 * MODLD * 4);
constexpr size_t WS_X = al(WS_ROPE + (size_t)NPOS * 64 * 8);
constexpr size_t WS_HN = al(WS_X + (size_t)M * D * 4);
constexpr size_t WS_Z = al(WS_HN + (size_t)M * D * 2);
constexpr size_t WS_MIX = al(WS_Z + (size_t)M * ZLD * 2);
constexpr size_t WS_H = al(WS_MIX + (size_t)M * D * 2);
constexpr size_t WS_RAW = al(WS_H + (size_t)M * D_FF * 2);
constexpr size_t WS_DSG = al(WS_RAW + (size_t)(M / 256) * 4 * 2 * D_FF * 4);
constexpr size_t WS_DSR = al(WS_DSG + (size_t)BATCH * NCH * 4 * DV_GLA * DK_GLA * 4);
constexpr size_t WS_SSG = al(WS_DSR + (size_t)BATCH * NCH * 4 * DV_RET * DK_RET * 4);
constexpr size_t WS_SSR = al(WS_SSG + (size_t)BATCH * NCH * 4 * DV_GLA * DK_GLA * 2);
constexpr size_t WS_DECG = al(WS_SSR + (size_t)BATCH * NCH * 4 * DV_RET * DK_RET * 2);
constexpr size_t WS_LAB = al(WS_DECG + (size_t)BATCH * NCH * 4 * DK_GLA * 4);
constexpr size_t WS_LHS = al(WS_LAB + (size_t)BATCH * NCH * W_LRU * 2 * 4);
constexpr size_t WS_SPL = al(WS_LHS + (size_t)BATCH * NCH * W_LRU * 4);
constexpr size_t WS_PART = al(WS_SPL + (size_t)DEPTH * W_LRU * 4);
constexpr size_t WS_RAWS = al(WS_PART + (size_t)3 * MS * D * 4);
constexpr size_t WS_LAG = al(WS_RAWS + (size_t)DEC_BATCH * 2 * 2 * D_FF * 4);
constexpr size_t WS_LUG = al(WS_LAG + (size_t)MP * W_LRU * 4);
constexpr size_t WS_END = al(WS_LUG + (size_t)MP * W_LRU * 4);
constexpr int CW_BAR = 4096;
constexpr int RING_BYTES = 131072;
constexpr int HALO_OFF = RING_BYTES;
constexpr int LDS_BYTES = 163840;
constexpr int MISC_OFF = LDS_BYTES - 256;
static_assert(HALO_OFF + 8192 <= MISC_OFF, "LDS map");

#define LDS_WAIT() asm volatile("s_waitcnt lgkmcnt(0)" ::: "memory")
#define VM_WAIT() asm volatile("s_waitcnt vmcnt(0)" ::: "memory")
__device__ __forceinline__ unsigned cvt_pk(float lo, float hi) { unsigned r; asm volatile("v_cvt_pk_bf16_f32 %0, %1, %2" : "=v"(r) : "v"(lo), "v"(hi)); return r; }
__device__ __forceinline__ unsigned short f2bf(float f) { return (unsigned short)(cvt_pk(f, 0.f) & 0xffffu); }
__device__ __forceinline__ float bf2f(unsigned short h) { return __builtin_bit_cast(float, (unsigned)h << 16); }
__device__ __forceinline__ float bflo(unsigned u) { return __builtin_bit_cast(float, u << 16); }
__device__ __forceinline__ float bfhi(unsigned u) { return __builtin_bit_cast(float, u & 0xffff0000u); }
__device__ __forceinline__ float fexp(float x) { return __expf(x); }
__device__ __forceinline__ float sigm(float x) { return __builtin_amdgcn_rcpf(1.f + __expf(-x)); }
__device__ __forceinline__ float siluf(float x) { return x * __builtin_amdgcn_rcpf(1.f + __expf(-x)); }
__device__ __forceinline__ float logsig(float x) { return fminf(x, 0.f) - __logf(1.f + __expf(-fabsf(x))); }
__device__ __forceinline__ float gelu_t(float x) { const float u = 0.7978845608028654f * (x + 0.044715f * x * x * x); return x * (1.f - __builtin_amdgcn_rcpf(1.f + __expf(2.f * u))); }
__device__ __forceinline__ int row_seq(int row) { return row < MP ? row / SEQ : BATCH + ((row - MP) >> 3); }
__device__ __forceinline__ float wave_sum(float v) {
#pragma unroll
    for (int o = 1; o < 64; o <<= 1) v += __shfl_xor(v, o);
    return v;
}

#define XB_TMO      128
#define XB_XCNT(j)  (256  + 64 * (j))
#define XB_XSUB(j)  (1280 + 64 * (j))
#define XB_XGEN(j)  (2304 + 64 * (j))
#define XB_TOP      3328
#define XB_TOPGEN   3392
#define XCD_BAR_WORDS 3456
#define XB_SPIN_CAP (1u << 18)
__device__ __forceinline__ unsigned xb_ld(unsigned* p)              { return __hip_atomic_load(p, __ATOMIC_RELAXED, __HIP_MEMORY_SCOPE_AGENT); }
__device__ __forceinline__ unsigned xb_add(unsigned* p, unsigned v) { return __hip_atomic_fetch_add(p, v, __ATOMIC_RELAXED, __HIP_MEMORY_SCOPE_AGENT); }
__device__ __forceinline__ unsigned xb_xcc_id() { return (unsigned)__builtin_amdgcn_s_getreg((3 << 11) | 20) & 0xFu; }
#define XB_SPIN(cond, bar) do { unsigned _sp = 0; while (cond) { __builtin_amdgcn_s_sleep(1); \
    if ((++_sp & 255u) == 0u) { if (xb_ld(&(bar)[XB_TMO])) break; if (_sp > XB_SPIN_CAP) { atomicAdd(&(bar)[XB_TMO], 1u); break; } } } } while (0)
struct XcdBarrier { unsigned* bar; unsigned x; volatile LAS unsigned* st; };
__device__ __forceinline__ XcdBarrier xcd_barrier_post(unsigned* bar, volatile LAS unsigned* st, bool tid0) {
    XcdBarrier b; b.bar = bar; b.x = xb_xcc_id(); b.st = st;
    if (tid0) (void)xb_add(&bar[XB_XCNT(b.x)], 1u);
    return b;
}
__device__ __forceinline__ void xcd_barrier_complete(unsigned* bar, unsigned x, unsigned& nloc, unsigned& nx) {
    const unsigned G = gridDim.x * gridDim.y * gridDim.z;
    unsigned sum, cnt, mine, sp = 0u;
    for (;;) {
        sum = 0u; cnt = 0u; mine = 0u;
#pragma unroll
        for (unsigned j = 0; j < 16; ++j) { const unsigned c = xb_ld(&bar[XB_XCNT(j)]); sum += c; cnt += (c > 0u) ? 1u : 0u; mine = (j == x) ? c : mine; }
        if (sum == G) break;
        __builtin_amdgcn_s_sleep(1);
        if ((++sp & 255u) == 0u) { if (xb_ld(&bar[XB_TMO])) break; if (sp > XB_SPIN_CAP) { atomicAdd(&bar[XB_TMO], 1u); break; } }
    }
    nloc = mine > 0u ? mine : 1u; nx = cnt > 0u ? cnt : 1u;
}
__device__ __forceinline__ void xcd_barrier(const XcdBarrier& b, bool tid0) {
    asm volatile("s_waitcnt vmcnt(0)" ::: "memory");
    __syncthreads();
    if (tid0) {
        unsigned* bar = b.bar; unsigned bx = b.x; asm volatile("" : "+s"(bar), "+s"(bx));
        __builtin_amdgcn_s_waitcnt(0);
        unsigned nloc = b.st[0], nx = b.st[1];
        if (nloc == 0u) { xcd_barrier_complete(bar, bx, nloc, nx); b.st[0] = nloc; b.st[1] = nx; }
        const unsigned old = xb_add(&bar[XB_XSUB(bx)], 1u);
        const unsigned gen = old / nloc;
        if (old + 1u == (gen + 1u) * nloc) {
            __builtin_amdgcn_fence(__ATOMIC_RELEASE, "agent");
            asm volatile("s_waitcnt vmcnt(0)" ::: "memory");
            const unsigned og = xb_add(&bar[XB_TOP], 1u);
            const unsigned tg = og / nx;
            if (og + 1u == (tg + 1u) * nx) xb_add(&bar[XB_TOPGEN], 1u);
            else XB_SPIN(xb_ld(&bar[XB_TOPGEN]) == tg, bar);
            __builtin_amdgcn_fence(__ATOMIC_ACQUIRE, "agent");
            xb_add(&bar[XB_XGEN(bx)], 1u);
            asm volatile("s_waitcnt vmcnt(0)" ::: "memory");
        } else {
            XB_SPIN(xb_ld(&bar[XB_XGEN(bx)]) == gen, bar);
            __builtin_amdgcn_fence(__ATOMIC_ACQUIRE, "agent");
            asm volatile("s_waitcnt vmcnt(0)" ::: "memory");
        }
    }
    __syncthreads();
}

#define INP(i) finp(F.inp, (i))
__device__ __forceinline__ const float* finp(const float* const* tab, int i) { asm volatile("" : "+s"(i)); return (const float*)(const GAS float*)tab[i]; }
__device__ __forceinline__ size_t fwo(unsigned o) { asm volatile("" : "+s"(o)); return (size_t)o << 8; }
struct Frame {
    LAS unsigned char* lds; volatile LAS unsigned* MISC;
    int wave, G, gw, NGW, umask;
    const float* const* inp; float* out; unsigned char* ws;
};

__device__ __forceinline__ void transpose_item(const float* W, int ldn, int src_col, int nvalid, bf16_t* WT, int Kd, int dst_row, int k0, LAS float* scr, int lane) {
    const bool ok = lane < nvalid; const float* p = W + (size_t)k0 * ldn + src_col + lane;
#pragma unroll
    for (int h = 0; h < 2; ++h) { float v[32];
#pragma unroll
        for (int i = 0; i < 32; ++i) v[i] = ok ? __builtin_nontemporal_load(p + (size_t)(32 * h + i) * ldn) : 0.f;
#pragma unroll
        for (int i = 0; i < 32; ++i) scr[(32 * h + i) * 65 + lane] = v[i]; }
    LDS_WAIT(); asm volatile("" ::: "memory");
    const int c = lane & 7;
#pragma unroll
    for (int j = 0; j < 8; ++j) { const int n = (lane >> 3) + 8 * j; const LAS float* s = scr + (8 * c) * 65 + n;
        u32x4 o; o.x = cvt_pk(s[0 * 65], s[1 * 65]); o.y = cvt_pk(s[2 * 65], s[3 * 65]); o.z = cvt_pk(s[4 * 65], s[5 * 65]); o.w = cvt_pk(s[6 * 65], s[7 * 65]);
        __builtin_nontemporal_store(o, (GAS u32x4*)(WT + (size_t)(dst_row + n) * Kd + k0 + 8 * c)); }
    LDS_WAIT(); asm volatile("" ::: "memory");
}
constexpr int I_IN = (D / 64) * (ZLD / 64), I_OUT = (D / 64) * (D / 64), I_UP = (D / 64) * (2 * D_FF / 64), I_DN = (D_FF / 64) * (D / 64), I_AD = (D / 64) * (6 * D / 64);
constexpr int PER_L4 = I_IN + I_OUT + I_UP + I_DN;
__device__ __forceinline__ void layer_item(Frame& F, int l, int r, LAS float* scr, int lane) {
    if (r < I_IN) { const int nblk = ZLD / 64, kb = r / nblk, n0 = 64 * (r % nblk); int src, nv;
        if (n0 < 1536) { src = n0; nv = 64; } else if (n0 < F_GLR) { src = n0 + 16; nv = 64; } else if (n0 == F_GLR) { src = Z_GLR; nv = 16; } else { src = 0; nv = 0; }
        transpose_item(INP(I_WIN) + (size_t)l * D * N_IN, N_IN, src, nv, ((bf16_t*)(F.ws + fwo((unsigned)(WS_WIN >> 8)))) + (size_t)l * ZLD * D, D, n0, 64 * kb, scr, lane); return; } r -= I_IN;
    if (r < I_OUT) { const int nblk = D / 64, kb = r / nblk, n0 = 64 * (r % nblk);
        transpose_item(INP(I_WOUT) + (size_t)l * D * D, D, n0, 64, ((bf16_t*)(F.ws + fwo((unsigned)(WS_WOUT >> 8)))) + (size_t)l * D * D, D, n0, 64 * kb, scr, lane); return; } r -= I_OUT;
    if (r < I_UP) { const int nblk = 2 * D_FF / 64, kb = r / nblk, n0 = 64 * (r % nblk), pn = n0 >> 8, c0 = n0 & 255; const int src = c0 < 128 ? 128 * pn + c0 : D_FF + 128 * pn + (c0 - 128);
        transpose_item(INP(I_WUP) + (size_t)l * D * 2 * D_FF, 2 * D_FF, src, 64, ((bf16_t*)(F.ws + fwo((unsigned)(WS_WUP >> 8)))) + (size_t)l * 2 * D_FF * D, D, n0, 64 * kb, scr, lane); return; } r -= I_UP;
    { const int nblk = D / 64, kb = r / nblk, n0 = 64 * (r % nblk);
        transpose_item(INP(I_WDOWN) + (size_t)l * D_FF * D, D, n0, 64, ((bf16_t*)(F.ws + fwo((unsigned)(WS_WDOWN >> 8)))) + (size_t)l * D * D_FF, D_FF, n0, 64 * kb, scr, lane); }
}
constexpr int CW_QUEUE = 8192, Q_CHUNK = 4, Q_TOTAL = DEPTH * PER_L4, Q_PRE = I_IN + I_OUT + (PER_L4 * 10) / 100;
__device__ __forceinline__ void steal_transposes(Frame& F, int cap) {
    if (cap > Q_TOTAL) cap = Q_TOTAL;
    const int lane = fresh_lane(), wave = fresh_s(F.wave); LAS float* scr = (LAS float*)(F.lds + wave * 16896);
    unsigned* ctr = (unsigned*)(F.ws + WS_CTL) + CW_QUEUE;
    for (;;) {
        if (Q_PRE + (int)__builtin_amdgcn_readfirstlane((int)__hip_atomic_load(ctr, __ATOMIC_RELAXED, __HIP_MEMORY_SCOPE_AGENT)) >= cap) break;
        unsigned base = 0u; if (lane == 0) base = __hip_atomic_fetch_add(ctr, (unsigned)Q_CHUNK, __ATOMIC_RELAXED, __HIP_MEMORY_SCOPE_AGENT);
        const int b0 = Q_PRE + __builtin_amdgcn_readfirstlane((int)base); if (b0 >= Q_TOTAL) break;
        for (int k = 0; k < Q_CHUNK && b0 + k < Q_TOTAL; ++k) { const int g = b0 + k; layer_item(F, g / PER_L4, g % PER_L4, scr, lane); }
    }
}
__device__ __forceinline__ int qcap(int l, int soft_pct, int need) { const int soft = l * PER_L4 + Q_PRE + (PER_L4 * soft_pct) / 100, must = l * PER_L4 + need; return soft > must ? soft : must; }
__device__ __forceinline__ void p0_prologue(Frame& F) {
    const int plane = fresh_lane(), pwave = fresh_s(F.wave), ptid = pwave * 64 + plane;
    LAS float* scr = (LAS float*)(F.lds + pwave * 16896);
    constexpr int NITEMS = (ADA_DIRECT ? Q_PRE : PER_L4 + DEPTH * I_AD);
    for (int it = fresh_s(F.gw); it < NITEMS; it += F.NGW) {
        if (it < (ADA_DIRECT ? Q_PRE : PER_L4)) { layer_item(F, 0, it, scr, plane); continue; }
        const int q = it - PER_L4, l = q / I_AD, r = q % I_AD; const int nblk = 6 * D / 64, kb = r / nblk, n0 = 64 * (r % nblk);
        transpose_item(INP(I_WADA) + (size_t)l * D * 6 * D, 6 * D, n0, 64, ((bf16_t*)(F.ws + fwo((unsigned)(WS_WADA >> 8)))) + (size_t)l * 6 * D * D, D, n0, 64 * kb, scr, plane);
    }
    const int gt = (int)blockIdx.x * NTHR + ptid, NGT = F.G * NTHR;
    const float* cpp = INP(I_CP); const float* csp = INP(I_CS);
    for (int i = gt; i < 256 * D / 2; i += NGT) { const int s = (2 * i) / D, k = (2 * i) % D; float a = 0.f, b = 0.f;
        if (s < NSEQ) { const float* c = s < BATCH ? cpp + (size_t)s * D : csp + (size_t)(s - BATCH) * D; a = siluf(c[k]); b = siluf(c[k + 1]); }
        ((unsigned*)((bf16_t*)(F.ws + fwo((unsigned)(WS_CACT >> 8)))))[i] = cvt_pk(a, b); }
    for (int i = gt; i < NPOS * 64; i += NGT) { const int p = i >> 6, j = i & 63; const int pos = p < SEQ ? p : PAST + (p - SEQ);
        const float fr = powf(10000.f, -(float)j / 64.f); const float ang = (float)pos * fr; float sn, cs; sincosf(ang, &sn, &cs); ((f32x2*)((float*)(F.ws + fwo((unsigned)(WS_ROPE >> 8)))))[i] = (f32x2){cs, sn}; }
    const float* lwa = INP(I_LWA); const float* lwx = INP(I_LWX);
    { constexpr int NTOT = DEPTH * 2 * 8 * 96 * 96; bf16_t* LW = ((bf16_t*)(F.ws + fwo((unsigned)(WS_LRUW >> 8))));
      for (int i0 = gt; i0 < NTOT; i0 += 5 * NGT) { float wv[5];
#pragma unroll
          for (int k = 0; k < 5; ++k) { const int i = i0 + k * NGT; wv[k] = 0.f;
              if (i < NTOT) { const int ii = i % 96, jo = (i / 96) % 96, g = (i / 9216) % 8, mat = (i / 73728) % 2, l = i / 147456; const float* W = mat ? lwx : lwa; wv[k] = W[(((size_t)l * 8 + g) * 96 + ii) * 96 + jo]; } }
#pragma unroll
          for (int k = 0; k < 5; ++k) { const int i = i0 + k * NGT; if (i < NTOT) LW[i] = f2bf(wv[k]); } } }
    { const float* lam = INP(I_LLAM); float* spl = ((float*)(F.ws + fwo((unsigned)(WS_SPL >> 8))));
      for (int i = gt; i < DEPTH * W_LRU; i += NGT) { const float x = -lam[i]; spl[i] = fmaxf(x, 0.f) + log1pf(expf(-fabsf(x))); } }
}

__device__ __forceinline__ void add_parts(Frame& F, int m, int lane, f32x4 (&v)[8]) {
    const float* P = ((float*)(F.ws + fwo((unsigned)(WS_PART >> 8)))) + (size_t)(m - MP) * D + 4 * lane; float* xw = ((float*)(F.ws + fwo((unsigned)(WS_X >> 8)))) + (size_t)m * D + 4 * lane;
#pragma unroll
    for (int j = 0; j < 8; ++j) { f32x4 a = v[j];
#pragma unroll
        for (int s = 0; s < SPLIT - 1; ++s) a += *(const f32x4*)(P + (size_t)s * MS * D + 256 * j);
        v[j] = a; *(f32x4*)(xw + 256 * j) = a; }
}
__device__ __forceinline__ void norm_phase(Frame& F, const float* g, int modoff_sh, int modoff_sc, bool has_part, const float* xp, const float* xs) {
    const int lane = fresh_lane(); const int m0 = fresh_s(F.gw);
    float* X = ((float*)(F.ws + fwo((unsigned)(WS_X >> 8)))); const float* MODp = ((float*)(F.ws + fwo((unsigned)(WS_MOD >> 8)))); bf16_t* HN = ((bf16_t*)(F.ws + fwo((unsigned)(WS_HN >> 8))));
    f32x4 gg[8], v[8];
#pragma unroll
    for (int j = 0; j < 8; ++j) gg[j] = *(const f32x4*)(g + 4 * lane + 256 * j);
    auto xrow = [&](int m) { return (const GAS f32x4*)(xp ? (m < MP ? xp + (size_t)m * D : xs + (size_t)(m - MP) * D) : X + (size_t)m * D) + lane; };
    if (m0 < M) { const GAS f32x4* xr = xrow(m0);
#pragma unroll
        for (int j = 0; j < 8; ++j) v[j] = xr[64 * j]; }
#pragma unroll 1
    for (int m = m0; m < M; m += F.NGW) {
        const float* mrow = MODp + (size_t)row_seq(m) * MODLD; f32x4 sc[8], sh[8], nx[8];
#pragma unroll
        for (int j = 0; j < 8; ++j) { sc[j] = *(const f32x4*)(mrow + modoff_sc + 4 * lane + 256 * j); sh[j] = *(const f32x4*)(mrow + modoff_sh + 4 * lane + 256 * j); }
        const int mn = m + F.NGW;
        if (mn < M) { const GAS f32x4* xr = xrow(mn);
#pragma unroll
            for (int j = 0; j < 8; ++j) nx[j] = xr[64 * j]; }
        if (has_part && m >= MP) add_parts(F, m, lane, v);
        float s = 0.f;
#pragma unroll
        for (int j = 0; j < 8; ++j) s += (v[j].x * v[j].x + v[j].y * v[j].y) + (v[j].z * v[j].z + v[j].w * v[j].w);
        const float rstd = rsqrtf(wave_sum(s) * (1.f / D) + 1e-6f);
        GAS u32x2* o8 = (GAS u32x2*)(HN + (size_t)m * D) + lane;
#pragma unroll
        for (int j = 0; j < 8; ++j) { const f32x4 y = (v[j] * rstd * gg[j]) * (sc[j] + 1.f) + sh[j]; o8[64 * j] = (u32x2){cvt_pk(y.x, y.y), cvt_pk(y.z, y.w)}; }
#pragma unroll
        for (int j = 0; j < 8; ++j) v[j] = nx[j];
    }
}
__device__ __forceinline__ void final_norm_phase(Frame& F) {
    const float* g = INP(I_FG);
    const int lane = fresh_lane(); const int m0 = fresh_s(F.gw);
    float* X = ((float*)(F.ws + fwo((unsigned)(WS_X >> 8))));
    f32x4 gg[8], v[8];
#pragma unroll
    for (int j = 0; j < 8; ++j) gg[j] = *(const f32x4*)(g + 4 * lane + 256 * j);
    if (m0 < M) { const GAS f32x4* xr = (const GAS f32x4*)(X + (size_t)m0 * D) + lane;
#pragma unroll
        for (int j = 0; j < 8; ++j) v[j] = xr[64 * j]; }
#pragma unroll 1
    for (int m = m0; m < M; m += F.NGW) { f32x4 nx[8]; const int mn = m + F.NGW;
        if (mn < M) { const GAS f32x4* xr = (const GAS f32x4*)(X + (size_t)mn * D) + lane;
#pragma unroll
            for (int j = 0; j < 8; ++j) nx[j] = xr[64 * j]; }
        if (m >= MP) add_parts(F, m, lane, v);
        float s = 0.f;
#pragma unroll
        for (int j = 0; j < 8; ++j) s += (v[j].x * v[j].x + v[j].y * v[j].y) + (v[j].z * v[j].z + v[j].w * v[j].w);
        const float rstd = rsqrtf(wave_sum(s) * (1.f / D) + 1e-6f);
        GAS f32x4* o = (GAS f32x4*)(F.out + O_YP + (size_t)m * D) + lane;
#pragma unroll
        for (int j = 0; j < 8; ++j) o[64 * j] = v[j] * rstd * gg[j];
#pragma unroll
        for (int j = 0; j < 8; ++j) v[j] = nx[j];
    }
}

struct EpiZ {
    static constexpr bool PERM = true, AFTER_DRAIN = false;
    bf16_t* O; int ldc;
    __device__ __forceinline__ void operator()(const f32x4 (&acc)[2][2][4][2], const pg8::Unit& u, int wr, int wc, int fr_, int fq_) const {
        int fr = fr_, fq = fq_; asm volatile("" : "+v"(fr), "+v"(fq));
        const int row0 = u.pm * 256 + wr * 64 + fr, col0 = u.pn * 256 + wc * 32 + 8 * fq;
#pragma unroll
        for (int ai = 0; ai < 2; ++ai)
#pragma unroll
            for (int m = 0; m < 4; ++m) { bf16_t* rowp = O + (size_t)(row0 + ai * 128 + m * 16) * ldc + col0;
#pragma unroll
                for (int bj = 0; bj < 2; ++bj) { const f32x4 v0 = acc[ai][bj][m][0], v1 = acc[ai][bj][m][1];
                    u32x4 w; w.x = cvt_pk(v0[0], v0[1]); w.y = cvt_pk(v0[2], v0[3]); w.z = cvt_pk(v1[0], v1[1]); w.w = cvt_pk(v1[2], v1[3]);
                    *(u32x4*)(rowp + bj * 128) = w; } }
    }
};
struct EpiMod {
    static constexpr bool PERM = false, AFTER_DRAIN = false;
    float* O; const float* bias;
    __device__ __forceinline__ void operator()(const f32x4 (&acc)[2][2][4][2], const pg8::Unit& u, int wr, int wc, int fr_, int fq_) const {
        int fr = fr_, fq = fq_; asm volatile("" : "+v"(fr), "+v"(fq));
        const int col0 = u.pn * 256 + wc * 32 + 4 * fq; f32x4 bv[2][2];
#pragma unroll
        for (int bj = 0; bj < 2; ++bj)
#pragma unroll
            for (int n = 0; n < 2; ++n) bv[bj][n] = *(const f32x4*)(bias + col0 + bj * 128 + n * 16);
#pragma unroll
        for (int ai = 0; ai < 2; ++ai)
#pragma unroll
            for (int m = 0; m < 4; ++m) { const int row = u.pm * 256 + ai * 128 + wr * 64 + m * 16 + fr;
                if (row < NSEQ) {
#pragma unroll
                    for (int bj = 0; bj < 2; ++bj)
#pragma unroll
                        for (int n = 0; n < 2; ++n) { const int col = col0 + bj * 128 + n * 16; *(f32x4*)(O + (size_t)row * MODLD + col) = acc[ai][bj][m][n] + bv[bj][n]; } } }
    }
};
#ifndef DBG_KEEPNORM
#define DBG_KEEPNORM 0
#endif
struct NormP { const float* g; const float* MOD; int sh, sc; bf16_t* HN; float* Y; const float* PART; unsigned* cnt; unsigned* tmo; LAS unsigned* flag; int on; };
__device__ __forceinline__ void st_wt(float* p, f32x4 v) {
    const f32x2 lo = {v[0], v[1]}, hi = {v[2], v[3]};
    __hip_atomic_store((unsigned long long*)p, __builtin_bit_cast(unsigned long long, lo), __ATOMIC_RELAXED, __HIP_MEMORY_SCOPE_AGENT);
    __hip_atomic_store((unsigned long long*)(p + 2), __builtin_bit_cast(unsigned long long, hi), __ATOMIC_RELAXED, __HIP_MEMORY_SCOPE_AGENT);
}
__device__ __forceinline__ void norm_one_row(const NormP& N, float* X, int m, int lane) {
    float* xrow = X + (size_t)m * D + 4 * lane; f32x4 v[8]; float s = 0.f;
#pragma unroll
    for (int j = 0; j < 8; ++j) v[j] = *(const f32x4*)(xrow + 256 * j);
    if (m >= MP) { const float* P = N.PART + (size_t)(m - MP) * D + 4 * lane;
#pragma unroll
        for (int j = 0; j < 8; ++j) { f32x4 a = v[j];
#pragma unroll
            for (int q = 0; q < SPLIT - 1; ++q) a += *(const f32x4*)(P + (size_t)q * MS * D + 256 * j);
            v[j] = a; *(f32x4*)(xrow + 256 * j) = a; } }
#pragma unroll
    for (int j = 0; j < 8; ++j) s += (v[j].x * v[j].x + v[j].y * v[j].y) + (v[j].z * v[j].z + v[j].w * v[j].w);
    const float rstd = rsqrtf(wave_sum(s) * (1.f / D) + 1e-6f);
    if (N.sh < 0) { float* y = N.Y + (size_t)m * D + 4 * lane;
#pragma unroll
        for (int j = 0; j < 8; ++j) *(f32x4*)(y + 256 * j) = v[j] * rstd * *(const f32x4*)(N.g + 4 * lane + 256 * j); }
    else { const float* mrow = N.MOD + (size_t)row_seq(m) * MODLD; u32x2* o8 = (u32x2*)(N.HN + (size_t)m * D) + lane;
#pragma unroll
        for (int j = 0; j < 8; ++j) { const int c = 4 * lane + 256 * j; const f32x4 gg = *(const f32x4*)(N.g + c), sc = *(const f32x4*)(mrow + N.sc + c), sh = *(const f32x4*)(mrow + N.sh + c);
            const f32x4 y = (v[j] * rstd * gg) * (sc + 1.f) + sh; o8[64 * j] = (u32x2){cvt_pk(y.x, y.y), cvt_pk(y.z, y.w)}; } }
}
struct EpiResGate {
    static constexpr bool PERM = false, AFTER_DRAIN = false;
    float* X; const float* MOD; float* PART; int goff, ks; float* DRY; const float* XP; const float* XS; NormP N;
    __device__ __forceinline__ void operator()(const f32x4 (&acc)[2][2][4][2], const pg8::Unit& u, int wr, int wc, int fr_, int fq_) const {
        int fr = fr_, fq = fq_; asm volatile("" : "+v"(fr), "+v"(fq));
        const int col0 = u.pn * 256 + wc * 32 + 4 * fq; const int slice = u.kb / ks; const bool fused = N.on && !DRY;
        const bool ptile = u.pm < MP / 256;
        if (ptile) {
            const float* mr = MOD + (size_t)(u.pm * 256 / SEQ) * MODLD + goff; f32x4 gm[2][2];
#pragma unroll
            for (int bj = 0; bj < 2; ++bj)
#pragma unroll
                for (int n = 0; n < 2; ++n) gm[bj][n] = *(const f32x4*)(mr + col0 + bj * 128 + n * 16);
#pragma unroll
            for (int ai = 0; ai < 2; ++ai) { f32x4 xo[4][2][2];
#pragma unroll
                for (int m = 0; m < 4; ++m) { const int row = u.pm * 256 + ai * 128 + wr * 64 + m * 16 + fr; const float* xi = DRY ? DRY + (size_t)row * D : (XP ? XP + (size_t)row * D : X + (size_t)row * D);
#pragma unroll
                    for (int bj = 0; bj < 2; ++bj)
#pragma unroll
                        for (int n = 0; n < 2; ++n) xo[m][bj][n] = *(const f32x4*)(xi + col0 + bj * 128 + n * 16); }
#pragma unroll
                for (int m = 0; m < 4; ++m) { const int row = u.pm * 256 + ai * 128 + wr * 64 + m * 16 + fr; float* xr = DRY ? DRY + (size_t)row * D : X + (size_t)row * D;
#pragma unroll
                    for (int bj = 0; bj < 2; ++bj)
#pragma unroll
                        for (int n = 0; n < 2; ++n) { const f32x4 v = xo[m][bj][n] + gm[bj][n] * acc[ai][bj][m][n]; if (fused) st_wt(xr + col0 + bj * 128 + n * 16, v); else *(f32x4*)(xr + col0 + bj * 128 + n * 16) = v; } } }
        } else {
#pragma unroll
            for (int ai = 0; ai < 2; ++ai)
#pragma unroll
                for (int mp = 0; mp < 4; mp += 2) { f32x4 xo[2][2][2], gm[2][2][2];
#pragma unroll
                    for (int mm = 0; mm < 2; ++mm) { const int row = u.pm * 256 + ai * 128 + wr * 64 + (mp + mm) * 16 + fr; const float* mr = MOD + (size_t)row_seq(row) * MODLD + goff;
                        const float* xi = DRY ? DRY + (size_t)row * D : (XS ? XS + (size_t)(row - MP) * D : X + (size_t)row * D);
#pragma unroll
                        for (int bj = 0; bj < 2; ++bj)
#pragma unroll
                            for (int n = 0; n < 2; ++n) { const int col = col0 + bj * 128 + n * 16; gm[mm][bj][n] = *(const f32x4*)(mr + col); xo[mm][bj][n] = (slice == 0) ? *(const f32x4*)(xi + col) : (f32x4){0.f, 0.f, 0.f, 0.f}; } }
#pragma unroll
                    for (int mm = 0; mm < 2; ++mm) { const int row = u.pm * 256 + ai * 128 + wr * 64 + (mp + mm) * 16 + fr;
                        float* xr = DRY ? DRY + (size_t)row * D : (slice == 0 ? X + (size_t)row * D : PART + ((size_t)(slice - 1) * MS + (row - MP)) * D);
#pragma unroll
                        for (int bj = 0; bj < 2; ++bj)
#pragma unroll
                            for (int n = 0; n < 2; ++n) { const int col = col0 + bj * 128 + n * 16; const f32x4 v = xo[mm][bj][n] + gm[mm][bj][n] * acc[ai][bj][mp + mm][n]; if (fused) st_wt(xr + col, v); else *(f32x4*)(xr + col) = v; } } }
        }
        if (fused) {
            const int wave = wr * 4 + wc, lane = fr + 16 * fq; const bool prompt = u.pm < MP / 256; const unsigned target = prompt ? 8u : 8u * SPLIT; unsigned* cw = N.cnt + 64 * u.pm;
            asm volatile("s_waitcnt vmcnt(0)" ::: "memory"); __builtin_amdgcn_s_barrier(); asm volatile("" ::: "memory");
            if (wave == 0) {
                if (lane == 0) (void)__hip_atomic_fetch_add(cw, 1u, __ATOMIC_RELAXED, __HIP_MEMORY_SCOPE_AGENT);
                unsigned sp = 0u;
                while (__hip_atomic_load(cw, __ATOMIC_RELAXED, __HIP_MEMORY_SCOPE_AGENT) < target) { __builtin_amdgcn_s_sleep(2);
                    if ((++sp & 1023u) == 0u) { if (__hip_atomic_load(N.tmo, __ATOMIC_RELAXED, __HIP_MEMORY_SCOPE_AGENT)) break; if (sp > (1u << 22)) { __hip_atomic_store(N.tmo, 1u, __ATOMIC_RELAXED, __HIP_MEMORY_SCOPE_AGENT); break; } } }
                __builtin_amdgcn_fence(__ATOMIC_ACQUIRE, "agent"); asm volatile("s_waitcnt vmcnt(0)" ::: "memory");
            }
            __builtin_amdgcn_s_barrier(); asm volatile("" ::: "memory");
            const int per = prompt ? 32 : 8, q = prompt ? u.pn : u.pn * SPLIT + slice;
            if (!DBG_KEEPNORM) for (int r = wave; r < per; r += 8) norm_one_row(N, X, u.pm * 256 + q * per + r, lane);
        }
    }
};
struct ResOrder {
    int G, c, ntFull, ks;
    __device__ bool next(int i, pg8::Unit& u) const {
        const int L = i * G + c;
        if (L < 256) { const int x = L & 7, y = (L >> 3) & 7, z = L >> 6; u.pm = 8 * (x >> 1) + y; u.pn = 4 * (x & 1) + z; u.kb = 0; u.nt = ntFull; return true; }
        const int q = L - 256; if (q >= 32 * SPLIT) return false;
        const int tile = q / SPLIT, s = q % SPLIT; u.pm = MP / 256 + (tile >> 3); u.pn = tile & 7; u.kb = s * ks; u.nt = ntFull / SPLIT; return true;
    }
    __device__ __forceinline__ void a_ready(const pg8::Unit&) const {}
    __device__ __forceinline__ void done(const pg8::Unit&) const {}
};
template <int N> __device__ __forceinline__ float ror16(float v) { return __builtin_bit_cast(float, __builtin_amdgcn_mov_dpp(__builtin_bit_cast(int, v), 0x120 + N, 0xf, 0xf, true)); }
struct EpiConvFfn {
    static constexpr bool PERM = true, AFTER_DRAIN = false;
    bf16_t* H; float* RAW; const float* cw; const float* cb; float* sbuf; float* sout; LAS float* halo; int skip;
    __device__ __forceinline__ void operator()(const f32x4 (&acc)[2][2][4][2], const pg8::Unit& u, int wr, int wc, int fr_, int fq_) const {
        int fr = fr_, fq = fq_; asm volatile("" : "+v"(fr), "+v"(fq));
        const bool sample = u.pm >= MP / 256;
        const int cc0 = wc * 32 + 8 * fq;
        if (fr >= 14) {
#pragma unroll
            for (int ai = 0; ai < 2; ++ai)
#pragma unroll
                for (int bj = 0; bj < 2; ++bj)
#pragma unroll
                    for (int n = 0; n < 2; ++n) *(LAS f32x4*)(halo + ((((ai * 2 + wr) * 4 + wc) * 2 + (fr - 14)) * 4 + bj * 2 + n) * 16 + 4 * fq) = acc[ai][bj][3][n];
        }
        const int cg0 = u.pn * 128 + cc0;
        f32x4 w0[2], w1[2], w2[2], bb[2];
#pragma unroll
        for (int bj = 0; bj < 2; ++bj) { const int col = bj * D_FF + cg0; w0[bj] = *(const f32x4*)(cw + col); w1[bj] = *(const f32x4*)(cw + 2 * D_FF + col); w2[bj] = *(const f32x4*)(cw + 4 * D_FF + col); bb[bj] = *(const f32x4*)(cb + col); }
        if (!sample) {
            float* rw = RAW + (size_t)u.pm * 4 * (2 * D_FF) + u.pn * 256 + cc0;
            if (wr == 0 && fr < 2) {
#pragma unroll
                for (int bj = 0; bj < 2; ++bj)
#pragma unroll
                    for (int n = 0; n < 2; ++n) *(f32x4*)(rw + (size_t)fr * (2 * D_FF) + bj * 128 + n * 4) = acc[0][bj][0][n]; }
            if (wr == 1 && fr >= 14) {
#pragma unroll
                for (int bj = 0; bj < 2; ++bj)
#pragma unroll
                    for (int n = 0; n < 2; ++n) *(f32x4*)(rw + (size_t)(fr - 12) * (2 * D_FF) + bj * 128 + n * 4) = acc[1][bj][3][n]; }
        }
        asm volatile("s_waitcnt lgkmcnt(0)" ::: "memory"); __builtin_amdgcn_s_barrier(); asm volatile("" ::: "memory");
        if (skip) return;
        u32x2 keep[2][4];
#pragma unroll
        for (int n = 0; n < 2; ++n) {
            if (n == 1) {
#pragma unroll
                for (int bj = 0; bj < 2; ++bj) { const int col = bj * D_FF + cg0 + 4; w0[bj] = *(const f32x4*)(cw + col); w1[bj] = *(const f32x4*)(cw + 2 * D_FF + col); w2[bj] = *(const f32x4*)(cw + 4 * D_FF + col); bb[bj] = *(const f32x4*)(cb + col); } }
#pragma unroll
            for (int ai = 0; ai < 2; ++ai) {
                const bool has_above = (wr == 1) || (ai == 1);
                const int hs = (wr == 1) ? (ai * 2 + 0) : ((ai - 1) * 2 + 1);
#pragma unroll
                for (int m = 0; m < 4; ++m) {
                    const int r = ai * 128 + wr * 64 + m * 16 + fr; const int row = u.pm * 256 + r;
                    f32x4 uu[2];
#pragma unroll
                    for (int bj = 0; bj < 2; ++bj) {
                        const f32x4 x0 = acc[ai][bj][m][n]; f32x4 xm1, xm2;
                        f32x4 h1 = {0.f, 0.f, 0.f, 0.f}, h2 = h1;
                        if (m == 0 && has_above) { h1 = *(const LAS f32x4*)(halo + (((hs * 4 + wc) * 2 + 1) * 4 + bj * 2 + n) * 16 + 4 * fq); h2 = *(const LAS f32x4*)(halo + (((hs * 4 + wc) * 2 + 0) * 4 + bj * 2 + n) * 16 + 4 * fq); }
                        f32x4 s1, s2;
#pragma unroll
                        for (int i = 0; i < 4; ++i) { const float prevm = (m > 0) ? acc[ai][bj][m > 0 ? m - 1 : 0][n][i] : 0.f; s1[i] = (fr == 15) ? prevm : x0[i]; s2[i] = (fr >= 14) ? prevm : x0[i]; }
#pragma unroll
                        for (int i = 0; i < 4; ++i) { xm1[i] = ror16<1>(s1[i]); xm2[i] = ror16<2>(s2[i]); }
                        if (m == 0) {
#pragma unroll
                            for (int i = 0; i < 4; ++i) { xm1[i] = (fr == 0) ? h1[i] : xm1[i]; xm2[i] = (fr == 0) ? h2[i] : ((fr == 1) ? h1[i] : xm2[i]); } }
                        if (sample) {
                            const int t = fr & 7; const int bs = (row - MP) >> 3; const int col = bj * D_FF + cg0 + 4 * n;
                            if (t < 2) *(f32x4*)(sbuf + ((size_t)bs * 2 + t) * (2 * D_FF) + col) = x0;
                            if (t >= 6) *(f32x4*)(sout + ((size_t)bs * 2 + (t - 6)) * (2 * D_FF) + col) = x0;
                        }
                        uu[bj] = w0[bj] * xm2 + w1[bj] * xm1 + w2[bj] * x0 + bb[bj];
                    }
                    const u32x2 pk = {cvt_pk(siluf(uu[0][0]) * uu[1][0], siluf(uu[0][1]) * uu[1][1]), cvt_pk(siluf(uu[0][2]) * uu[1][2], siluf(uu[0][3]) * uu[1][3])};
                    if (n == 0) keep[ai][m] = pk;
                    else *(u32x4*)(H + (size_t)row * D_FF + cg0) = (u32x4){keep[ai][m].x, keep[ai][m].y, pk.x, pk.y};
                }
            }
            asm volatile("" ::: "memory");
        }
    }
};
template <int KIND> struct MK {
    static constexpr int DK = KIND ? DK_RET : DK_GLA, DV = KIND ? DV_RET : DV_GLA;
    static constexpr int QO = KIND ? F_RQ : F_GQ, KO = KIND ? F_RK : F_GK, VO = KIND ? F_RV : F_GV, GO = KIND ? F_RG : F_GG, MO = KIND ? (W_GLA + W_LRU) : 0;
    static constexpr int RSK = DK * 2 + 16, RSV = DV * 2 + 16, NKS = DK / 32, NJB = DV / 16;
    static constexpr float QSCALE = KIND ? 0.08838834764831845f : 0.10206207261596575f;
};
constexpr int HTHR = 256, HALF_LDS = 73728;
constexpr int L_QD = 0, L_KD = 17408, L_V = 34816, L_ATT = 60416, L_GLR = L_ATT  , L_BQ = 69632, RSA = 144;
static_assert(L_BQ + 2048 <= HALF_LDS && 2 * HALF_LDS <= MISC_OFF, "half LDS map");
__device__ __forceinline__ unsigned lds_addr(LAS const void* p) { return (unsigned)(unsigned long)p; }
__device__ __forceinline__ f32x4 mma(bf16x8 first, bf16x8 second, f32x4 c) { return __builtin_amdgcn_mfma_f32_16x16x32_bf16(first, second, c, 0, 0, 0); }
__device__ __forceinline__ unsigned pk_rne(float lo, float hi) { unsigned a = __builtin_bit_cast(unsigned, lo), b = __builtin_bit_cast(unsigned, hi); a += 0x7fffu + ((a >> 16) & 1u); b += 0x7fffu + ((b >> 16) & 1u); return (a >> 16) | (b & 0xffff0000u); }
__device__ __forceinline__ bf16x8 row_frag(LAS const unsigned char* img, int RS, int row, int k0) { return *(const LAS bf16x8*)(img + row * RS + k0 * 2); }
template <int RS> __device__ __forceinline__ bf16x8 tr_frag(LAS const unsigned char* img, int kbase, int colbase, int fr, int fq) {
    const unsigned a = lds_addr(img) + (unsigned)((kbase + 8 * fq + (fr >> 2)) * RS + (colbase + 4 * (fr & 3)) * 2);
    s16x4 lo, hi;
    asm volatile("ds_read_b64_tr_b16 %0, %2\n\tds_read_b64_tr_b16 %1, %2 offset:%3\n\ts_waitcnt lgkmcnt(0)" : "=&v"(lo), "=&v"(hi) : "v"(a), "i"(4 * RS) : "memory");
    return (bf16x8){lo[0], lo[1], lo[2], lo[3], hi[0], hi[1], hi[2], hi[3]};
}
__device__ __forceinline__ float ret_logg(int h) { return log1pf(-exp2f(-5.f - (float)h)); }

struct Half { LAS unsigned char* lds; LAS unsigned* cnt; unsigned tgt; int hid; };
__device__ __forceinline__ void hbar(Half& H, int lane) {
    asm volatile("s_waitcnt lgkmcnt(0)" ::: "memory");
    H.tgt += 4u;
    if (lane == 0) (void)__hip_atomic_fetch_add(H.cnt, 1u, __ATOMIC_RELAXED, __HIP_MEMORY_SCOPE_WORKGROUP);
    while (__hip_atomic_load(H.cnt, __ATOMIC_RELAXED, __HIP_MEMORY_SCOPE_WORKGROUP) < H.tgt) __builtin_amdgcn_s_sleep(1);
    asm volatile("" ::: "memory");
}
struct LP { const float *gwa, *gba, *gng, *rng, *lcw, *lcb, *lba, *lbx, *spl, *sgla, *sret, *slru, *slconv; };

template <int KIND, int MODE> __device__ __forceinline__ void mix_prompt_unit(Frame& F, Half& H, const LP& P, int l, int b, int c, int h) {
    typedef MK<KIND> K; constexpr int DK = K::DK, DV = K::DV, RSK = K::RSK, RSV = K::RSV;
    const int lane = fresh_lane(), wid = fresh_s(F.wave) & 3, tid = wid * 64 + lane, fr = lane & 15, fq = lane >> 4;
    LAS unsigned char* lds = H.lds;
    const size_t row0 = (size_t)b * SEQ + 64 * c;
    const bf16_t* zr = ((bf16_t*)(F.ws + fwo((unsigned)(WS_Z >> 8)))) + row0 * ZLD;
    const size_t ubase = ((size_t)(b * NCH + c) * 4 + h);
    if (KIND == 0 && tid < 128) { const int t = tid >> 1, hf = tid & 1; const u32x4 w = *(const u32x4*)(zr + (size_t)t * ZLD + F_GLR + 8 * hf); LAS float* g = (LAS float*)(lds + L_GLR) + t * 16 + 8 * hf;
        g[0] = bflo(w.x); g[1] = bfhi(w.x); g[2] = bflo(w.y); g[3] = bfhi(w.y); g[4] = bflo(w.z); g[5] = bfhi(w.z); g[6] = bflo(w.w); g[7] = bfhi(w.w); }
    for (int it = tid; it < 64 * (DV / 8); it += HTHR) { const int s = it / (DV / 8), jo = (it % (DV / 8)) * 8;
        *(LAS u32x4*)(lds + L_V + s * RSV + jo * 2) = *(const u32x4*)(zr + (size_t)s * ZLD + K::VO + h * DV + jo); }
    for (int it = tid; it < 64 * (DK / 8); it += HTHR) { const int s = it / (DK / 8), jo = (it % (DK / 8)) * 8;
        *(LAS u32x4*)(lds + L_KD + s * RSK + jo * 2) = *(const u32x4*)(zr + (size_t)s * ZLD + K::KO + h * DK + jo);
        if (MODE == 1) *(LAS u32x4*)(lds + L_QD + s * RSK + jo * 2) = *(const u32x4*)(zr + (size_t)s * ZLD + K::QO + h * DK + jo); }
    u32x2 gtv[K::NJB]; f32x4 g4v[K::NJB];
    if (MODE == 1) { const bf16_t* ztp = zr + (size_t)(16 * wid + fr) * ZLD + K::GO + h * DV; const float* ngp = (KIND ? P.rng : P.gng) + h * DV;
#pragma unroll
        for (int jb = 0; jb < K::NJB; ++jb) { const int j0 = 16 * jb + 4 * fq; gtv[jb] = *(const u32x2*)(ztp + j0); g4v[jb] = *(const f32x4*)(ngp + j0); } }
    hbar(H, lane);
    float blast = 0.f;
    if (F.umask & 0x200) {} else
    if (KIND == 0) {
        const int d = tid % DK, th = tid / DK; const bool act = tid < 2 * DK; float cb[32];
        if (act) { float wcol[16]; const float* wa = P.gwa + h * DK + d;
#pragma unroll
            for (int r = 0; r < 16; ++r) wcol[r] = wa[r * 384];
            const float bias = P.gba[h * DK + d]; float cum = 0.f;
#pragma unroll
            for (int tt = 0; tt < 32; ++tt) { const LAS f32x4* g = (const LAS f32x4*)(lds + L_GLR) + (32 * th + tt) * 4; float u = bias;
#pragma unroll
                for (int r4 = 0; r4 < 4; ++r4) { const f32x4 gv = g[r4]; u += gv[0] * wcol[4 * r4] + gv[1] * wcol[4 * r4 + 1] + gv[2] * wcol[4 * r4 + 2] + gv[3] * wcol[4 * r4 + 3]; }
                cum += logsig(u) * (1.f / 16.f); cb[tt] = cum; }
            ((LAS float*)(lds + L_BQ))[th * 128 + d] = cum; }
        hbar(H, lane);
        if (act) { const LAS float* bq = (const LAS float*)(lds + L_BQ); const float v0 = bq[d], v1 = bq[128 + d]; blast = v0 + v1; const float pre = th ? v0 : 0.f;
#pragma unroll
            for (int tt = 0; tt < 32; ++tt) { const int t = 32 * th + tt; const float bt = pre + cb[tt];
                LAS bf16_t* kp = (LAS bf16_t*)(lds + L_KD + t * RSK) + d; const float k = bf2f(*kp);
                if (MODE == 1) { LAS bf16_t* qp = (LAS bf16_t*)(lds + L_QD + t * RSK) + d; const float q = bf2f(*qp); *qp = f2bf(q * K::QSCALE * fexp(bt)); *kp = f2bf(k * fexp(-bt)); }
                else *kp = f2bf(k * fexp(blast - bt)); }
            if (MODE == 0 && th == 0) ((float*)(F.ws + fwo((unsigned)(WS_DECG >> 8))))[ubase * DK + d] = fexp(blast); }
    } else {
        const int i = tid & 63, tq = tid >> 6; const float lg = ret_logg(h); blast = 64.f * lg;
        const f32x2* rope = ((const f32x2*)((float*)(F.ws + fwo((unsigned)(WS_ROPE >> 8))))) + (size_t)(64 * c + 16 * tq) * 64 + i; f32x2 cs[16];
#pragma unroll
        for (int tt = 0; tt < 16; ++tt) cs[tt] = rope[tt * 64];
#pragma unroll
        for (int tt = 0; tt < 16; ++tt) { const int t = 16 * tq + tt; const float bt = (float)(t + 1) * lg;
            LAS bf16_t* kp = (LAS bf16_t*)(lds + L_KD + t * RSK) + i; const float k1 = bf2f(kp[0]), k2 = bf2f(kp[64]); const float kr1 = k1 * cs[tt].x - k2 * cs[tt].y, kr2 = k1 * cs[tt].y + k2 * cs[tt].x;
            if (MODE == 1) { LAS bf16_t* qp = (LAS bf16_t*)(lds + L_QD + t * RSK) + i; const float q1 = bf2f(qp[0]), q2 = bf2f(qp[64]); const float e = K::QSCALE * fexp(bt), ek = fexp(-bt);
                qp[0] = f2bf((q1 * cs[tt].x - q2 * cs[tt].y) * e); qp[64] = f2bf((q1 * cs[tt].y + q2 * cs[tt].x) * e); kp[0] = f2bf(kr1 * ek); kp[64] = f2bf(kr2 * ek); }
            else { const float ek = fexp(blast - bt); kp[0] = f2bf(kr1 * ek); kp[64] = f2bf(kr2 * ek); } }
    }
    hbar(H, lane);
    if (F.umask & 0x400) {} else
    if (MODE == 0) {
        constexpr int NDB = DK / 16, JPW = K::NJB / 4;
        bf16_t* DS = (KIND ? ((bf16_t*)(F.ws + fwo((unsigned)(WS_DSR >> 8)))) : ((bf16_t*)(F.ws + fwo((unsigned)(WS_DSG >> 8))))) + ubase * (size_t)(DV * DK);
#pragma unroll 1
        for (int q = 0; q < JPW; ++q) { const int jb = wid * JPW + q;
            const bf16x8 a0 = tr_frag<RSV>(lds + L_V, 0, 16 * jb, fr, fq), a1 = tr_frag<RSV>(lds + L_V, 32, 16 * jb, fr, fq);
#pragma unroll 2
            for (int db = 0; db < NDB; ++db) { const bf16x8 b0 = tr_frag<RSK>(lds + L_KD, 0, 16 * db, fr, fq), b1 = tr_frag<RSK>(lds + L_KD, 32, 16 * db, fr, fq);
                f32x4 acc = {0.f, 0.f, 0.f, 0.f}; acc = mma(b0, a0, acc); acc = mma(b1, a1, acc);
                *(u32x2*)(DS + (size_t)(16 * jb + fr) * DK + 16 * db + 4 * fq) = (u32x2){pk_rne(acc[0], acc[1]), pk_rne(acc[2], acc[3])}; } }
    } else {
#pragma unroll 1
        for (int p = wid; p < 12; p += 4) { f32x4 acc = {0.f, 0.f, 0.f, 0.f};
            if (p >= 10) { const int tb = p == 10 ? 0 : 2, sb = tb + 1; *(LAS u32x2*)(lds + L_ATT + (16 * tb + fr) * RSA + (16 * sb + 4 * fq) * 2) = (u32x2){0u, 0u}; continue; }
            const int tb = p >= 6 ? 3 : (p >= 3 ? 2 : (p >= 1 ? 1 : 0)), sb = p - tb * (tb + 1) / 2;
#pragma unroll
            for (int ks = 0; ks < K::NKS; ++ks) { const bf16x8 a = row_frag(lds + L_QD, RSK, 16 * tb + fr, 32 * ks + 8 * fq), bt = row_frag(lds + L_KD, RSK, 16 * sb + fr, 32 * ks + 8 * fq); acc = mma(bt, a, acc); }
            if (sb == tb) {
#pragma unroll
                for (int i = 0; i < 4; ++i) if (4 * fq + i > fr) acc[i] = 0.f; }
            *(LAS u32x2*)(lds + L_ATT + (16 * tb + fr) * RSA + (16 * sb + 4 * fq) * 2) = (u32x2){pk_rne(acc[0], acc[1]), pk_rne(acc[2], acc[3])}; }
        hbar(H, lane);
        const int tb = wid; f32x4 acc[K::NJB];
#pragma unroll
        for (int jb = 0; jb < K::NJB; ++jb) acc[jb] = (f32x4){0.f, 0.f, 0.f, 0.f};
        const int nksa = tb >= 2 ? 2 : 1;
#pragma unroll 1
        for (int ks = 0; ks < nksa; ++ks) { const bf16x8 a = row_frag(lds + L_ATT, RSA, 16 * tb + fr, 32 * ks + 8 * fq);
#pragma unroll
            for (int jb = 0; jb < K::NJB; ++jb) { const bf16x8 bt = tr_frag<RSV>(lds + L_V, 32 * ks, 16 * jb, fr, fq); acc[jb] = mma(bt, a, acc[jb]); } }
        if (c > 0) { const bf16_t* SS = (KIND ? ((bf16_t*)(F.ws + fwo((unsigned)(WS_SSR >> 8)))) : ((bf16_t*)(F.ws + fwo((unsigned)(WS_SSG >> 8))))) + ubase * (size_t)(DV * DK);
#pragma unroll
            for (int ks = 0; ks < K::NKS; ++ks) { const bf16x8 a = row_frag(lds + L_QD, RSK, 16 * tb + fr, 32 * ks + 8 * fq);
#pragma unroll
                for (int jb = 0; jb < K::NJB; ++jb) { const bf16x8 bt = *(const bf16x8*)(SS + (size_t)(16 * jb + fr) * DK + 32 * ks + 8 * fq); acc[jb] = mma(bt, a, acc[jb]); } } }
        float ss = 0.f;
#pragma unroll
        for (int jb = 0; jb < K::NJB; ++jb) ss += (acc[jb][0] * acc[jb][0] + acc[jb][1] * acc[jb][1]) + (acc[jb][2] * acc[jb][2] + acc[jb][3] * acc[jb][3]);
        ss += __shfl_xor(ss, 16); ss += __shfl_xor(ss, 32);
        const int t = 16 * tb + fr; const float rstd = rsqrtf(ss * (1.f / DV) + 1e-6f);
        bf16_t* mo = ((bf16_t*)(F.ws + fwo((unsigned)(WS_MIX >> 8)))) + (row0 + t) * D + K::MO + h * DV;
#pragma unroll
        for (int jb = 0; jb < K::NJB; ++jb) { const int j0 = 16 * jb + 4 * fq; const f32x4 g4 = g4v[jb]; const u32x2 gt = gtv[jb];
            const f32x4 y = {acc[jb][0] * rstd * g4[0] * siluf(bflo(gt.x)), acc[jb][1] * rstd * g4[1] * siluf(bfhi(gt.x)), acc[jb][2] * rstd * g4[2] * siluf(bflo(gt.y)), acc[jb][3] * rstd * g4[3] * siluf(bfhi(gt.y))};
            *(u32x2*)(mo + j0) = (u32x2){cvt_pk(y[0], y[1]), cvt_pk(y[2], y[3])}; }
    }
    hbar(H, lane);
}

template <int KIND> __device__ __forceinline__ void mix_sample_unit(Frame& F, Half& H, const LP& P, int l, int bs, int h) {
    typedef MK<KIND> K; constexpr int DK = K::DK, DV = K::DV, J4 = DV / 4, NG = KIND ? 8 : 4, DPG = DK / NG;
    const int lane = fresh_lane(), wid = fresh_s(F.wave) & 3, tid = wid * 64 + lane;
    LAS float* Q = (LAS float*)H.lds;
    LAS float* KX = Q + 1024;
    LAS float* BC = KX + 1024;
    LAS float* QDT = BC + 1024;
    LAS float* KKT = QDT + 1024;
    LAS float* EBL = KKT + 1024;
    LAS float* V = EBL + 128;
    LAS float* ATT = V + 1536;
    LAS float* OP = ATT + 64;
    const size_t row0 = (size_t)MP + 8 * bs; const bf16_t* zr = ((bf16_t*)(F.ws + fwo((unsigned)(WS_Z >> 8)))) + row0 * ZLD;
    const size_t sbase = (((size_t)l * DEC_BATCH + bs) * 4 + h) * (size_t)(DK * DV); const int j4 = tid % J4, grp = tid / J4; const bool sact = tid < NG * J4;
    const float* S0 = (KIND ? P.sret : P.sgla) + sbase;
    f32x4 s0v[DPG];
    if (sact) {
#pragma unroll
        for (int dd = 0; dd < DPG; ++dd) s0v[dd] = __builtin_nontemporal_load((const f32x4*)(S0 + (size_t)(grp * DPG + dd) * DV + 4 * j4)); }
    for (int i = tid; i < 8 * DV; i += HTHR) { const int t = i / DV, j = i % DV; V[t * 192 + j] = bf2f(zr[(size_t)t * ZLD + K::VO + h * DV + j]); }
    if (tid < DK) { const int d = tid; float wcol[16]; float bias = 0.f;
        if (KIND == 0) { const float* wa = P.gwa + h * DK + d;
#pragma unroll
            for (int r = 0; r < 16; ++r) wcol[r] = wa[r * 384];
            bias = P.gba[h * DK + d]; }
        const float lg = KIND ? ret_logg(h) : 0.f; float cum = 0.f; float bt[8], qv[8], kv[8];
#pragma unroll
        for (int t = 0; t < 8; ++t) { const bf16_t* zt = zr + (size_t)t * ZLD;
            if (KIND == 0) { float u = bias; const u32x4 g0 = *(const u32x4*)(zt + F_GLR), g1 = *(const u32x4*)(zt + F_GLR + 8);
                u += bflo(g0.x) * wcol[0] + bfhi(g0.x) * wcol[1] + bflo(g0.y) * wcol[2] + bfhi(g0.y) * wcol[3] + bflo(g0.z) * wcol[4] + bfhi(g0.z) * wcol[5] + bflo(g0.w) * wcol[6] + bfhi(g0.w) * wcol[7];
                u += bflo(g1.x) * wcol[8] + bfhi(g1.x) * wcol[9] + bflo(g1.y) * wcol[10] + bfhi(g1.y) * wcol[11] + bflo(g1.z) * wcol[12] + bfhi(g1.z) * wcol[13] + bflo(g1.w) * wcol[14] + bfhi(g1.w) * wcol[15];
                cum += logsig(u) * (1.f / 16.f); qv[t] = bf2f(zt[K::QO + h * DK + d]); kv[t] = bf2f(zt[K::KO + h * DK + d]); }
            else { cum += lg; const int i = d & 63; const f32x2 cs = ((const f32x2*)((float*)(F.ws + fwo((unsigned)(WS_ROPE >> 8)))))[(size_t)(SEQ + t) * 64 + i];
                const float q1 = bf2f(zt[K::QO + h * DK + i]), q2 = bf2f(zt[K::QO + h * DK + 64 + i]), k1 = bf2f(zt[K::KO + h * DK + i]), k2 = bf2f(zt[K::KO + h * DK + 64 + i]);
                qv[t] = d < 64 ? q1 * cs.x - q2 * cs.y : q1 * cs.y + q2 * cs.x; kv[t] = d < 64 ? k1 * cs.x - k2 * cs.y : k1 * cs.y + k2 * cs.x; }
            bt[t] = cum; }
        f32x4 qa, qb, ka, kb;
#pragma unroll
        for (int t = 0; t < 8; ++t) { Q[t * 128 + d] = qv[t] * K::QSCALE; KX[t * 128 + d] = kv[t]; BC[t * 128 + d] = bt[t];
            const float qd = qv[t] * K::QSCALE * fexp(bt[t]), kk = kv[t] * fexp(cum - bt[t]); if (t < 4) { qa[t] = qd; ka[t] = kk; } else { qb[t - 4] = qd; kb[t - 4] = kk; } }
        *(LAS f32x4*)(QDT + d * 8) = qa; *(LAS f32x4*)(QDT + d * 8 + 4) = qb; *(LAS f32x4*)(KKT + d * 8) = ka; *(LAS f32x4*)(KKT + d * 8 + 4) = kb;
        EBL[d] = fexp(cum); }
    hbar(H, lane);
    { const int pair = tid >> 2, part = tid & 3, t = pair >> 3, s = pair & 7; float a = 0.f;
      if (s <= t) for (int d = part; d < DK; d += 4) a += Q[t * 128 + d] * KX[s * 128 + d] * fexp(BC[t * 128 + d] - BC[s * 128 + d]);
      a += __shfl_xor(a, 1); a += __shfl_xor(a, 2);
      if (part == 0) ATT[t * 8 + s] = a; }
    hbar(H, lane);
    if (sact) { f32x4 v[8], op[8];
#pragma unroll
        for (int t = 0; t < 8; ++t) { v[t] = *(const LAS f32x4*)(V + t * 192 + 4 * j4); op[t] = (f32x4){0.f, 0.f, 0.f, 0.f}; }
        float* S1 = F.out + (KIND ? O_RET_S : O_GLA_S) + sbase;
#pragma unroll
        for (int dd = 0; dd < DPG; ++dd) { const int d = grp * DPG + dd; const f32x4 s0 = s0v[dd];
            const f32x4 ka = *(const LAS f32x4*)(KKT + d * 8), kb = *(const LAS f32x4*)(KKT + d * 8 + 4), qa = *(const LAS f32x4*)(QDT + d * 8), qb = *(const LAS f32x4*)(QDT + d * 8 + 4);
            f32x4 sn = s0 * EBL[d];
#pragma unroll
            for (int t = 0; t < 4; ++t) { sn += v[t] * ka[t]; sn += v[t + 4] * kb[t]; op[t] += s0 * qa[t]; op[t + 4] += s0 * qb[t]; }
            __builtin_nontemporal_store(sn, (f32x4*)(S1 + (size_t)d * DV + 4 * j4));
            if ((dd & 3) == 3) asm volatile("" ::: "memory"); }
        if (grp == 0) {
#pragma unroll
            for (int t = 0; t < 8; ++t)
#pragma unroll
                for (int s = 0; s < 8; ++s) if (s <= t) op[t] += v[s] * ATT[t * 8 + s]; }
#pragma unroll
        for (int t = 0; t < 8; ++t) *(LAS f32x4*)(OP + (grp * 8 + t) * DV + 4 * j4) = op[t]; }
    hbar(H, lane);
    const float* ng = (KIND ? P.rng : P.gng) + h * DV;
    { float gz[2][3], gn[3];
#pragma unroll
      for (int k = 0; k < DV / 64; ++k) { gn[k] = ng[lane + 64 * k];
#pragma unroll
          for (int tk = 0; tk < 2; ++tk) gz[tk][k] = bf2f(zr[(size_t)(wid + 4 * tk) * ZLD + K::GO + h * DV + lane + 64 * k]); }
#pragma unroll
      for (int tk = 0; tk < 2; ++tk) { const int t = wid + 4 * tk; float o[3]; float ss = 0.f;
#pragma unroll
        for (int k = 0; k < DV / 64; ++k) { const int j = lane + 64 * k; float a = 0.f;
#pragma unroll
            for (int g = 0; g < NG; ++g) a += OP[(g * 8 + t) * DV + j];
            o[k] = a; ss += a * a; }
        const float rstd = rsqrtf(wave_sum(ss) * (1.f / DV) + 1e-6f);
        bf16_t* mo = ((bf16_t*)(F.ws + fwo((unsigned)(WS_MIX >> 8)))) + (row0 + t) * D + K::MO + h * DV;
#pragma unroll
        for (int k = 0; k < DV / 64; ++k) { const int j = lane + 64 * k; mo[j] = f2bf(o[k] * rstd * gn[k] * siluf(gz[tk][k])); } } }
    hbar(H, lane);
}

constexpr int LL_XE = 0, LL_XC = 33792, LL_LA = 47104, LL_PH = LL_XC  , RSX = 208;
static_assert(LL_LA + 24576 <= HALF_LDS, "LRU LDS map");
__device__ __forceinline__ float neg_expm1(float x) {
    const float s = x * (1.f + x * (0.5f + x * (0.16666667f + x * (0.041666668f + x * (0.0083333338f + x * 0.0013888889f))))); return x > -0.25f ? -s : 1.f - __expf(x); }
template <int MODE, bool SAMPLE> __device__ __forceinline__ void lru_unit(Frame& F, Half& H, const LP& P, int l, int rc, int g) {
    const int lane = fresh_lane(), wid = fresh_s(F.wave) & 3, tid = wid * 64 + lane, fr = lane & 15, fq = lane >> 4;
    LAS unsigned char* lds = H.lds; LAS float* XE = (LAS float*)(lds + LL_XE); LAS float* U = XE; LAS float* LA = (LAS float*)(lds + LL_LA); LAS float* PH = (LAS float*)(lds + LL_PH);
    constexpr bool sample = SAMPLE; constexpr int L = SAMPLE ? 8 : 64, nseg = SAMPLE ? 8 : 1;
    const size_t row0 = (size_t)rc * 64; const bf16_t* zb = ((bf16_t*)(F.ws + fwo((unsigned)(WS_Z >> 8)))) + row0 * ZLD; const bf16_t* zr = zb + F_LX + g * 96;
    const int pb = rc / NCH, pc = rc % NCH;
    for (int it = tid; it < nseg * (L + 3) * 12; it += HTHR) { const int ir = it / 12, c8 = (it % 12) * 8; const int seg = ir / (L + 3), tp = ir % (L + 3) - 3;
        LAS float* dst = XE + ir * 96 + c8; f32x4 lo = {0.f, 0.f, 0.f, 0.f}, hi = lo;
        if (tp >= 0 || (!sample && pc > 0)) { const u32x4 w = *(const u32x4*)(zr + ((long)seg * L + tp) * (long)ZLD + c8); lo = (f32x4){bflo(w.x), bfhi(w.x), bflo(w.y), bfhi(w.y)}; hi = (f32x4){bflo(w.z), bfhi(w.z), bflo(w.w), bfhi(w.w)}; }
        else if (sample) { const int bs = (rc - MP / 64) * 8 + seg; const float* sb = P.slconv + ((size_t)bs * 3 + (tp + 3)) * W_LRU + g * 96 + c8; lo = *(const f32x4*)sb; hi = *(const f32x4*)(sb + 4); }
        *(LAS f32x4*)dst = lo; *(LAS f32x4*)(dst + 4) = hi; }
    hbar(H, lane);
    LAS float* XF = LA;
    if (tid < 192) { const int ch = tid % 96, ts = tid / 96; const float* cw = P.lcw + g * 96 + ch; const float w0 = cw[0], w1 = cw[W_LRU], w2 = cw[2 * W_LRU], w3 = cw[3 * W_LRU], cbv = P.lcb[g * 96 + ch];
#pragma unroll 4
        for (int k = 0; k < 32; ++k) { const int t = ts + 2 * k; const int ir = (t / L) * (L + 3) + 3 + (t % L);
            const float xc = w0 * XE[(ir - 3) * 96 + ch] + w1 * XE[(ir - 2) * 96 + ch] + w2 * XE[(ir - 1) * 96 + ch] + w3 * XE[ir * 96 + ch] + cbv;
            XF[t * 96 + ch] = xc; ((LAS bf16_t*)(lds + LL_XC + t * RSX))[ch] = f2bf(xc); }
        if (ts == 0 && (sample ? MODE == 1 : MODE == 0)) {
            if (!sample) { if (pc == NCH - 1) {
#pragma unroll
                for (int k = 0; k < 3; ++k) F.out[O_LCONV_P + (((size_t)l * BATCH + pb) * 3 + k) * W_LRU + g * 96 + ch] = XE[(3 + 61 + k) * 96 + ch]; } }
            else {
#pragma unroll 1
                for (int seg = 0; seg < 8; ++seg) { const int bs = (rc - MP / 64) * 8 + seg;
#pragma unroll
                    for (int k = 0; k < 3; ++k) F.out[O_LCONV_S + (((size_t)l * DEC_BATCH + bs) * 3 + k) * W_LRU + g * 96 + ch] = XE[(seg * 11 + 3 + 5 + k) * 96 + ch]; } } } }
    hbar(H, lane);
    { const int tb = wid; f32x4 acc[2][6];
#pragma unroll
      for (int m = 0; m < 2; ++m)
#pragma unroll
          for (int jb = 0; jb < 6; ++jb) acc[m][jb] = (f32x4){0.f, 0.f, 0.f, 0.f};
      const bf16_t* WT = ((bf16_t*)(F.ws + fwo((unsigned)(WS_LRUW >> 8)))) + ((((size_t)l * 2) * 8 + g) * 96) * 96;
#pragma unroll 1
      for (int ks = 0; ks < 3; ++ks) { const bf16x8 a = row_frag(lds + LL_XC, RSX, 16 * tb + fr, 32 * ks + 8 * fq);
#pragma unroll
          for (int m = 0; m < 2; ++m)
#pragma unroll
              for (int jb = 0; jb < 6; ++jb) { const bf16x8 bt = *(const bf16x8*)(WT + (size_t)m * (8 * 96 * 96) + (size_t)(16 * jb + fr) * 96 + 32 * ks + 8 * fq); acc[m][jb] = mma(bt, a, acc[m][jb]); } }
      const int t = 16 * tb + fr; const float* ba = P.lba + g * 96; const float* bx = P.lbx + g * 96; const float* sp = P.spl + g * 96;
#pragma unroll
      for (int jb = 0; jb < 6; ++jb) { const int j0 = 16 * jb + 4 * fq; const f32x4 bav = *(const f32x4*)(ba + j0), bxv = *(const f32x4*)(bx + j0), spv = *(const f32x4*)(sp + j0); const f32x4 xf = *(const LAS f32x4*)(XF + t * 96 + j0); f32x4 o, u;
#pragma unroll
          for (int i = 0; i < 4; ++i) { const float la = -LRU_C * sigm(acc[0][jb][i] + bav[i]) * spv[i]; o[i] = fexp(la); u[i] = __builtin_amdgcn_sqrtf(neg_expm1(2.f * la)) * sigm(acc[1][jb][i] + bxv[i]) * xf[i]; }
          *(LAS f32x4*)(LA + t * 96 + j0) = o; *(LAS f32x4*)(U + t * 96 + j0) = u; } }
    hbar(H, lane);
    const int ch = tid % 96, qh = tid / 96; const bool act = tid < 192;
    float Pp = 1.f, Hh = 0.f;
    if (act && !sample) {
        unsigned* ag = ((unsigned*)(F.ws + fwo((unsigned)(WS_LAG >> 8)))) + (row0 + 32 * qh) * W_LRU + g * 96 + ch;
#pragma unroll 8
        for (int tt = 0; tt < 32; ++tt) { const int idx = (32 * qh + tt) * 96 + ch; const float a = LA[idx], u = U[idx]; Hh = a * Hh + u; Pp *= a;
            if (MODE == 0) ag[(size_t)tt * W_LRU] = pk_rne(__builtin_amdgcn_logf(a), u); }
    }
    bf16_t* mo = ((bf16_t*)(F.ws + fwo((unsigned)(WS_MIX >> 8)))) + row0 * D + W_GLA + g * 96 + ch; const bf16_t* zg = zb + F_LG + g * 96 + ch;
    if (!sample) {
        if (act) { PH[(qh * 96 + ch) * 2] = Pp; PH[(qh * 96 + ch) * 2 + 1] = Hh; }
        hbar(H, lane);
        if (act) {
            const size_t sidx = ((size_t)(pb * NCH + pc)) * W_LRU + g * 96 + ch;
            float hc = (MODE == 1) ? ((float*)(F.ws + fwo((unsigned)(WS_LHS >> 8))))[sidx] : 0.f;
            if (qh == 1) hc = PH[ch * 2] * hc + PH[ch * 2 + 1];
            if (MODE == 0) { if (qh == 1) { float* lab = ((float*)(F.ws + fwo((unsigned)(WS_LAB >> 8)))); lab[sidx * 2] = PH[ch * 2] * Pp; lab[sidx * 2 + 1] = Pp * hc + Hh; } }
            else {
                bf16_t gv[32];
#pragma unroll
                for (int tt = 0; tt < 32; ++tt) gv[tt] = zg[(size_t)(32 * qh + tt) * ZLD];
#pragma unroll
                for (int tt = 0; tt < 32; ++tt) { const int t = 32 * qh + tt; hc = LA[t * 96 + ch] * hc + U[t * 96 + ch]; mo[(size_t)t * D] = f2bf(hc * gelu_t(bf2f(gv[tt]))); }
                if (pc == NCH - 1 && qh == 1) F.out[O_LRU_P + ((size_t)l * BATCH + pb) * W_LRU + g * 96 + ch] = hc; }
        }
    } else if (MODE == 1) {
        if (act) {
            bf16_t gv[32]; float h0v[4];
#pragma unroll
            for (int tt = 0; tt < 32; ++tt) gv[tt] = zg[(size_t)(32 * qh + tt) * ZLD];
#pragma unroll
            for (int sg = 0; sg < 4; ++sg) h0v[sg] = P.slru[(size_t)((rc - MP / 64) * 8 + 4 * qh + sg) * W_LRU + g * 96 + ch];
#pragma unroll
            for (int sg = 0; sg < 4; ++sg) { const int seg = 4 * qh + sg; const int bs = (rc - MP / 64) * 8 + seg; const size_t si = (size_t)bs * W_LRU + g * 96 + ch;
                float hc = h0v[sg];
#pragma unroll
                for (int tt = 0; tt < 8; ++tt) { const int t = 8 * seg + tt; hc = LA[t * 96 + ch] * hc + U[t * 96 + ch]; mo[(size_t)t * D] = f2bf(hc * gelu_t(bf2f(gv[8 * sg + tt]))); }
                F.out[O_LRU_S + (size_t)l * DEC_BATCH * W_LRU + si] = hc; } }
    }
    hbar(H, lane);
}

__device__ __forceinline__ void lru_out_unit(Frame& F, Half& H, const LP& P, int l, int rc, int g) {
    const int lane = fresh_lane(), wid = fresh_s(F.wave) & 3, tid = wid * 64 + lane;
    LAS float* PH = (LAS float*)H.lds;
    const int ch = tid % 96, qh = tid / 96; const bool act = tid < 192; const int pb = rc / NCH, pc = rc % NCH; const size_t row0 = (size_t)rc * 64;
    unsigned wv[32]; bf16_t gv[32]; float hs = 0.f;
    if (act) { const unsigned* ag = ((const unsigned*)(F.ws + fwo((unsigned)(WS_LAG >> 8)))) + (row0 + 32 * qh) * W_LRU + g * 96 + ch;
        const bf16_t* zg = ((bf16_t*)(F.ws + fwo((unsigned)(WS_Z >> 8)))) + (row0 + 32 * qh) * ZLD + F_LG + g * 96 + ch;
#pragma unroll
        for (int tt = 0; tt < 32; ++tt) { wv[tt] = ag[(size_t)tt * W_LRU]; gv[tt] = zg[(size_t)tt * ZLD]; }
        hs = ((float*)(F.ws + fwo((unsigned)(WS_LHS >> 8))))[((size_t)(pb * NCH + pc)) * W_LRU + g * 96 + ch];
        if (qh == 0) { float Pp = 1.f, Hh = 0.f;
#pragma unroll
            for (int tt = 0; tt < 32; ++tt) { const float a = __builtin_amdgcn_exp2f(__builtin_bit_cast(float, wv[tt] << 16)); Hh = a * Hh + __builtin_bit_cast(float, wv[tt] & 0xffff0000u); Pp *= a; }
            PH[ch * 2] = Pp; PH[ch * 2 + 1] = Hh; } }
    hbar(H, lane);
    if (act) { float hc = hs; if (qh == 1) hc = PH[ch * 2] * hc + PH[ch * 2 + 1];
        bf16_t* mo = ((bf16_t*)(F.ws + fwo((unsigned)(WS_MIX >> 8)))) + (row0 + 32 * qh) * D + W_GLA + g * 96 + ch;
#pragma unroll
        for (int tt = 0; tt < 32; ++tt) { hc = __builtin_amdgcn_exp2f(__builtin_bit_cast(float, wv[tt] << 16)) * hc + __builtin_bit_cast(float, wv[tt] & 0xffff0000u); mo[(size_t)tt * D] = f2bf(hc * gelu_t(bf2f(gv[tt]))); }
        if (pc == NCH - 1 && qh == 1) F.out[O_LRU_P + ((size_t)l * BATCH + pb) * W_LRU + g * 96 + ch] = hc; }
    hbar(H, lane);
}

constexpr int U_PG = BATCH * NCH * 4;
constexpr int U_PL = BATCH * NCH * 8;
constexpr int U_SG = DEC_BATCH * 4;
constexpr int U_SL = (MS / 64) * 8;
__device__ __forceinline__ LP make_lp(Frame& F, int l) {
    LP P; P.gwa = INP(I_GWA) + (size_t)l * GLA_RANK * 384; P.gba = INP(I_GBA) + (size_t)l * 384; P.gng = INP(I_GNG) + (size_t)l * W_GLA; P.rng = INP(I_RNG) + (size_t)l * W_RET;
    P.lcw = INP(I_LCW) + (size_t)l * 4 * W_LRU; P.lcb = INP(I_LCB) + (size_t)l * W_LRU; P.lba = INP(I_LBA) + (size_t)l * W_LRU; P.lbx = INP(I_LBX) + (size_t)l * W_LRU;
    P.spl = ((float*)(F.ws + fwo((unsigned)(WS_SPL >> 8)))) + (size_t)l * W_LRU;
    P.sgla = INP(I_SGLA); P.sret = INP(I_SRET); P.slru = INP(I_SLRU) + (size_t)l * DEC_BATCH * W_LRU; P.slconv = INP(I_SLCONV) + (size_t)l * DEC_BATCH * 3 * W_LRU;
    return P;
}
#ifndef UMASK
#define UMASK 0xFF
#endif
#define UM(k) ((F.umask >> (k)) & 1)
#define HUNIT_LOOP(NU_, OFF_, BODY_) do { for (int r = (int)(((unsigned)wk + (unsigned)NW - (unsigned)((OFF_) % NW)) % (unsigned)NW); r < (NU_); r += NW) { BODY_; } } while (0)
__device__ __forceinline__ void phase_ma(Frame& F, Half& H, int l) {
    const LP P = make_lp(F, l); const int NW = 2 * F.G, wk = 2 * (int)blockIdx.x + H.hid;
    if (UM(5)) HUNIT_LOOP(U_PL, 0, (lru_unit<0, false>(F, H, P, l, r >> 3, r & 7)));
    if (UM(0)) HUNIT_LOOP(U_SG, U_PL, mix_sample_unit<0>(F, H, P, l, r >> 2, r & 3));
    if (UM(1)) HUNIT_LOOP(U_SG, U_PL + U_SG, mix_sample_unit<1>(F, H, P, l, r >> 2, r & 3));
    if (UM(3)) HUNIT_LOOP(U_PG, U_PL + 2 * U_SG, (mix_prompt_unit<0, 0>(F, H, P, l, r / (NCH * 4), (r >> 2) % NCH, r & 3)));
    if (UM(4)) HUNIT_LOOP(U_PG, U_PL + 2 * U_SG + U_PG, (mix_prompt_unit<1, 0>(F, H, P, l, r / (NCH * 4), (r >> 2) % NCH, r & 3)));
    if (UM(2)) HUNIT_LOOP(U_SL, U_PL + 2 * U_SG + 2 * U_PG, (lru_unit<1, true>(F, H, P, l, MP / 64 + (r >> 3), r & 7)));
}
__device__ __forceinline__ void phase_mc(Frame& F, Half& H, int l) {
    const LP P = make_lp(F, l); const int NW = 2 * F.G, wk = 2 * (int)blockIdx.x + H.hid;
    if (UM(6)) HUNIT_LOOP(U_PG, 0, (mix_prompt_unit<0, 1>(F, H, P, l, r / (NCH * 4), (r >> 2) % NCH, r & 3)));
    if (UM(7)) HUNIT_LOOP(U_PG, U_PG, (mix_prompt_unit<1, 1>(F, H, P, l, r / (NCH * 4), (r >> 2) % NCH, r & 3)));
    if (UM(2)) HUNIT_LOOP(U_PL, 2 * U_PG, lru_out_unit(F, H, P, l, r >> 3, r & 7));
}
template <int KIND> __device__ __forceinline__ void mb_item(Frame& F, int l, int it) {
    typedef MK<KIND> K; constexpr int DK = K::DK, DV = K::DV, NQ = KIND ? 2 : 1, QPR = DK / (4 * NQ);
    const int dq = it % QPR, j = (it / QPR) % DV, h = (it / (QPR * DV)) % 4, b = it / (QPR * DV * 4); const int d0 = 4 * NQ * dq;
    const bf16_t* DS = KIND ? ((bf16_t*)(F.ws + fwo((unsigned)(WS_DSR >> 8)))) : ((bf16_t*)(F.ws + fwo((unsigned)(WS_DSG >> 8)))); bf16_t* SS = KIND ? ((bf16_t*)(F.ws + fwo((unsigned)(WS_SSR >> 8)))) : ((bf16_t*)(F.ws + fwo((unsigned)(WS_SSG >> 8))));
    f32x4 S[NQ]; f32x4 cdec = {0.f, 0.f, 0.f, 0.f}; if (KIND) { const float e = fexp(64.f * ret_logg(h)); cdec = (f32x4){e, e, e, e}; }
#pragma unroll
    for (int q = 0; q < NQ; ++q) S[q] = (f32x4){0.f, 0.f, 0.f, 0.f};
    const float* DECp = ((float*)(F.ws + fwo((unsigned)(WS_DECG >> 8))));
#pragma unroll 1
    for (int c0 = 0; c0 < NCH; c0 += 16) { u32x2 ds[16][NQ]; f32x4 dc[16];
#pragma unroll
        for (int k = 0; k < 16; ++k) { const size_t ub = (size_t)(b * NCH + c0 + k) * 4 + h; dc[k] = KIND ? cdec : *(const f32x4*)(DECp + ub * DK + d0);
#pragma unroll
            for (int q = 0; q < NQ; ++q) ds[k][q] = __builtin_nontemporal_load((const u32x2*)(DS + ub * (size_t)(DV * DK) + (size_t)j * DK + d0 + 4 * q)); }
#pragma unroll
        for (int k = 0; k < 16; ++k) { const size_t ub = (size_t)(b * NCH + c0 + k) * 4 + h; const size_t e = ub * (size_t)(DV * DK) + (size_t)j * DK + d0;
#pragma unroll
            for (int q = 0; q < NQ; ++q) { *(u32x2*)(SS + e + 4 * q) = (u32x2){cvt_pk(S[q][0], S[q][1]), cvt_pk(S[q][2], S[q][3])};
                const f32x4 dv = {__builtin_bit_cast(float, ds[k][q].x << 16), __builtin_bit_cast(float, ds[k][q].x & 0xffff0000u), __builtin_bit_cast(float, ds[k][q].y << 16), __builtin_bit_cast(float, ds[k][q].y & 0xffff0000u)};
                S[q] = dc[k] * S[q] + dv; } } }
    float* o = F.out + (KIND ? O_RET_P : O_GLA_P) + (((size_t)l * BATCH + b) * 4 + h) * (size_t)(DK * DV) + j;
#pragma unroll
    for (int q = 0; q < NQ; ++q)
#pragma unroll
        for (int i = 0; i < 4; ++i) o[(size_t)(d0 + 4 * q + i) * DV] = S[q][i];
}
__device__ __forceinline__ void phase_mb(Frame& F, int l) {
    constexpr int NG_ = BATCH * 4 * DV_GLA * (DK_GLA / 4), NR_ = BATCH * 4 * DV_RET * (DK_RET / 8), NL_ = BATCH * W_LRU;
    const int gt = (int)blockIdx.x * NTHR + fresh_s(F.wave) * 64 + fresh_lane(), NGT = F.G * NTHR;
    for (int it = gt; it < NG_ + NR_ + NL_; it += NGT) {
        if (it < NG_) mb_item<0>(F, l, it);
        else if (it < NG_ + NR_) mb_item<1>(F, l, it - NG_);
        else { const int r = it - NG_ - NR_, b = r / W_LRU, ch = r % W_LRU; float hc = 0.f;
            const float* lab = ((float*)(F.ws + fwo((unsigned)(WS_LAB >> 8)))); float* lhs = ((float*)(F.ws + fwo((unsigned)(WS_LHS >> 8)))); f32x2 ab[NCH];
#pragma unroll
            for (int c = 0; c < NCH; ++c) ab[c] = *(const f32x2*)(lab + ((size_t)(b * NCH + c) * W_LRU + ch) * 2);
#pragma unroll
            for (int c = 0; c < NCH; ++c) { lhs[(size_t)(b * NCH + c) * W_LRU + ch] = hc; hc = ab[c].x * hc + ab[c].y; } }
    }
}
__device__ __forceinline__ void phase_fx(Frame& F, int l) {
    const int gt = (int)blockIdx.x * NTHR + fresh_s(F.wave) * 64 + fresh_lane(), NGT = F.G * NTHR;
    const float* cw = INP(I_FCW) + (size_t)l * 3 * 2 * D_FF; const float* cb = INP(I_FCB) + (size_t)l * 2 * D_FF;
    for (int it = gt; it < (MP / 256) * (D_FF / 4); it += NGT) { const int pm = it / (D_FF / 4), f = 4 * (it % (D_FF / 4)), pn = f >> 7, cc = f & 127;
        const float* R1 = ((float*)(F.ws + fwo((unsigned)(WS_RAW >> 8)))) + (size_t)pm * 4 * (2 * D_FF) + pn * 256 + cc;
        if ((pm & 7) != 0) { const float* R0 = R1 - 4 * (2 * D_FF);
            f32x4 ug[2], uv[2];
#pragma unroll
            for (int p = 0; p < 2; ++p) { const int col = p * D_FF + f;
                const f32x4 xm2 = *(const f32x4*)(R0 + 2 * (2 * D_FF) + p * 128), xm1 = *(const f32x4*)(R0 + 3 * (2 * D_FF) + p * 128), x0 = *(const f32x4*)(R1 + p * 128), x1 = *(const f32x4*)(R1 + (2 * D_FF) + p * 128);
                const f32x4 w0 = *(const f32x4*)(cw + col), w1 = *(const f32x4*)(cw + 2 * D_FF + col), w2 = *(const f32x4*)(cw + 4 * D_FF + col), bb = *(const f32x4*)(cb + col);
                const f32x4 u0 = w0 * xm2 + w1 * xm1 + w2 * x0 + bb, u1 = w0 * xm1 + w1 * x0 + w2 * x1 + bb;
                if (p == 0) { ug[0] = u0; ug[1] = u1; } else { uv[0] = u0; uv[1] = u1; } }
            bf16_t* hp = ((bf16_t*)(F.ws + fwo((unsigned)(WS_H >> 8)))) + ((size_t)pm * 256) * D_FF + f;
#pragma unroll
            for (int r = 0; r < 2; ++r) *(u32x2*)(hp + (size_t)r * D_FF) = (u32x2){cvt_pk(siluf(ug[r][0]) * uv[r][0], siluf(ug[r][1]) * uv[r][1]), cvt_pk(siluf(ug[r][2]) * uv[r][2], siluf(ug[r][3]) * uv[r][3])}; }
        if ((pm & 7) == 7) { const int b = pm >> 3;
#pragma unroll
            for (int p = 0; p < 2; ++p)
#pragma unroll
                for (int k = 0; k < 2; ++k) *(f32x4*)(F.out + O_FCONV_P + (((size_t)l * BATCH + b) * 2 + k) * (2 * D_FF) + p * D_FF + f) = *(const f32x4*)(R1 + (size_t)(2 + k) * (2 * D_FF) + p * 128); }
    }
    const float* sb = INP(I_SFCONV) + (size_t)l * DEC_BATCH * 2 * 2 * D_FF; const float* RS = ((float*)(F.ws + fwo((unsigned)(WS_RAWS >> 8))));
    for (int it = gt; it < DEC_BATCH * (D_FF / 4); it += NGT) { const int bs = it / (D_FF / 4), f = 4 * (it % (D_FF / 4)); f32x4 ug[2], uv[2];
#pragma unroll
        for (int p = 0; p < 2; ++p) { const int col = p * D_FF + f;
            const f32x4 b0 = *(const f32x4*)(sb + ((size_t)bs * 2 + 0) * (2 * D_FF) + col), b1 = *(const f32x4*)(sb + ((size_t)bs * 2 + 1) * (2 * D_FF) + col), x0 = *(const f32x4*)(RS + ((size_t)bs * 2 + 0) * (2 * D_FF) + col), x1 = *(const f32x4*)(RS + ((size_t)bs * 2 + 1) * (2 * D_FF) + col);
            const f32x4 w0 = *(const f32x4*)(cw + col), w1 = *(const f32x4*)(cw + 2 * D_FF + col), w2 = *(const f32x4*)(cw + 4 * D_FF + col), bb = *(const f32x4*)(cb + col);
            const f32x4 u0 = w0 * b0 + w1 * b1 + w2 * x0 + bb, u1 = w0 * b1 + w1 * x0 + w2 * x1 + bb;
            if (p == 0) { ug[0] = u0; ug[1] = u1; } else { uv[0] = u0; uv[1] = u1; } }
        bf16_t* hp = ((bf16_t*)(F.ws + fwo((unsigned)(WS_H >> 8)))) + ((size_t)MP + 8 * bs) * D_FF + f;
#pragma unroll
        for (int r = 0; r < 2; ++r) *(u32x2*)(hp + (size_t)r * D_FF) = (u32x2){cvt_pk(siluf(ug[r][0]) * uv[r][0], siluf(ug[r][1]) * uv[r][1]), cvt_pk(siluf(ug[r][2]) * uv[r][2], siluf(ug[r][3]) * uv[r][3])}; }
}

constexpr int AD_RSW = 400, AD_RSA = 144, AD_WB = 64 * AD_RSW, AD_AB = 144 * AD_RSA, AD_A0 = 2 * AD_WB;
static_assert(AD_A0 + 2 * AD_AB <= MISC_OFF, "adaln_direct LDS");
__device__ __forceinline__ void ad_load_w(f32x4 (&r)[6], const float* wp, int ck) {
    const float* q = wp + (size_t)ck * 64 * (6 * D);
#pragma unroll
    for (int p = 0; p < 2; ++p)
#pragma unroll
        for (int i = 0; i < 3; ++i) r[p * 3 + i] = __builtin_nontemporal_load((const f32x4*)(q + (size_t)p * 32 * (6 * D) + 64 * i));
}
__device__ __forceinline__ void ad_write_w(const f32x4 (&r)[6], LAS unsigned char* wl) {
#pragma unroll
    for (int p = 0; p < 2; ++p)
#pragma unroll
        for (int i = 0; i < 3; ++i) *(LAS u32x2*)(wl + p * 32 * AD_RSW + i * 128) = (u32x2){cvt_pk(r[p * 3 + i][0], r[p * 3 + i][1]), cvt_pk(r[p * 3 + i][2], r[p * 3 + i][3])};
}
__device__ __forceinline__ void ad_load_a(u32x4 (&r)[3], const bf16_t* CA, int c, int tid) {
#pragma unroll
    for (int j = 0; j < 3; ++j) { const int v = tid + 512 * j; r[j] = (u32x4){0u, 0u, 0u, 0u}; if (v < 144 * 8) r[j] = *(const u32x4*)(CA + (size_t)(v >> 3) * D + 64 * c + 8 * (v & 7)); }
}
__device__ __forceinline__ void ad_write_a(const u32x4 (&r)[3], LAS unsigned char* ab, int tid) {
#pragma unroll
    for (int j = 0; j < 3; ++j) { const int v = tid + 512 * j; if (v < 144 * 8) *(LAS u32x4*)(ab + (v >> 3) * AD_RSA + (v & 7) * 16) = r[j]; }
}
__device__ __forceinline__ void ad_compute(f32x4 (&acc)[5][3], LAS const unsigned char* wb, LAS const unsigned char* ab, int kofs, int mg, int ng, int fr, int fq) {
#pragma unroll
    for (int ks = 0; ks < 2; ++ks) { bf16x8 b[3];
#pragma unroll
        for (int t = 0; t < 3; ++t) b[t] = tr_frag<AD_RSW>(wb, 32 * ks, 16 * (3 * ng + t), fr, fq);
#pragma unroll
        for (int mt = 0; mt < 5; ++mt) { if (mt == 4 && mg == 1) continue; const bf16x8 a = row_frag(ab, AD_RSA, 16 * (5 * mg + mt) + fr, kofs + 32 * ks + 8 * fq);
#pragma unroll
            for (int t = 0; t < 3; ++t) acc[mt][t] = mma(b[t], a, acc[mt][t]); } }
}
__device__ __forceinline__ void adaln_direct(Frame& F) {
    const int lane = fresh_lane(), wave = fresh_s(F.wave), tid = wave * 64 + lane, fr = lane & 15, fq = lane >> 4, mg = wave >> 2, ng = wave & 3;
    const bf16_t* CA = ((bf16_t*)(F.ws + fwo((unsigned)(WS_CACT >> 8)))); float* MOD = ((float*)(F.ws + fwo((unsigned)(WS_MOD >> 8)))); const float* bias = INP(I_BADA);
    LAS unsigned char* lds = F.lds;
    for (int st = (int)blockIdx.x; st < MODLD / 192; st += F.G) {
        const int l = st / (6 * D / 192), n0 = (st % (6 * D / 192)) * 192;
        const float* W = INP(I_WADA) + (size_t)l * D * (6 * D) + n0;
        f32x4 acc[5][3];
#pragma unroll
        for (int mt = 0; mt < 5; ++mt)
#pragma unroll
            for (int t = 0; t < 3; ++t) acc[mt][t] = (f32x4){0.f, 0.f, 0.f, 0.f};
        f32x4 w0[6], w1[6], w2[6]; u32x4 ar[3];
        const float* wp = W + (size_t)(4 * wave + (lane >> 4)) * (6 * D) + 4 * (lane & 15); LAS unsigned char* wl = lds + (4 * wave + (lane >> 4)) * AD_RSW + (lane & 15) * 8;
        ad_load_a(ar, CA, 0, tid); ad_load_w(w0, wp, 0); ad_load_w(w1, wp, 1); ad_load_w(w2, wp, 2);
        ad_write_a(ar, lds + AD_A0, tid); ad_load_a(ar, CA, 1, tid);
        constexpr int NC = D / 64;
#define AD_SLOT(WS_, J_) { const int c = 6 * i + (J_); if (c < NC) { \
            ad_write_w(WS_, wl + ((J_) & 1) * AD_WB); \
            asm volatile("s_waitcnt lgkmcnt(0)" ::: "memory"); __syncthreads(); \
            ad_write_a(ar, lds + AD_A0 + (((J_) + 1) & 1) * AD_AB, tid); \
            ad_load_w(WS_, wp, min(c + 3, NC - 1)); ad_load_a(ar, CA, min(c + 2, NC - 1), tid); \
            ad_compute(acc, lds + ((J_) & 1) * AD_WB, lds + AD_A0 + ((J_) & 1) * AD_AB, 0, mg, ng, fr, fq); } }
#pragma unroll 1
        for (int i = 0; i < (NC + 5) / 6; ++i) { AD_SLOT(w0, 0) AD_SLOT(w1, 1) AD_SLOT(w2, 2) AD_SLOT(w0, 3) AD_SLOT(w1, 4) AD_SLOT(w2, 5) }
#undef AD_SLOT
#pragma unroll
        for (int t = 0; t < 3; ++t) { const int col = l * 6 * D + n0 + 16 * (3 * ng + t) + 4 * fq; const f32x4 bb = *(const f32x4*)(bias + col);
#pragma unroll
            for (int mt = 0; mt < 5; ++mt) { const int m = 16 * (5 * mg + mt) + fr; if (m < NSEQ) *(f32x4*)(MOD + (size_t)m * MODLD + col) = acc[mt][t] + bb; } }
        __syncthreads();
    }
}

struct Args { const float* in[N_INPUTS]; float* out; unsigned char* ws; int ph_lo, ph_hi, umask, pad; };
#ifndef G2_SPLIT
#define G2_SPLIT 4
#endif
#ifndef G4_SPLIT
#define G4_SPLIT 4
#endif
#ifndef DBG_KEEPNORM
#define DBG_KEEPNORM 0
#endif
#ifndef WGM_G1
#define WGM_G1 12
#endif
#ifndef WGM_G3
#define WGM_G3 12
#endif
constexpr int CW_PAN = 16384;
constexpr int PH_PER_LAYER = 10, PH_TOTAL = 2 + DEPTH * PH_PER_LAYER + 1;
__global__ void __launch_bounds__(NTHR, 2) mega(Args args) {
    extern __shared__ __attribute__((aligned(16))) unsigned char lds[];
    Frame F;
    F.lds = (LAS unsigned char*)lds; F.MISC = (volatile LAS unsigned*)(F.lds + MISC_OFF);
    F.wave = __builtin_amdgcn_readfirstlane((int)threadIdx.x >> 6); asm volatile("" : "+s"(F.wave)); F.G = gridDim.x; F.gw = (int)blockIdx.x * NWAVES + F.wave; F.NGW = F.G * NWAVES;
    F.inp = args.in; F.umask = args.umask;
    F.out = args.out; unsigned char* ws = args.ws; F.ws = ws;
    if (threadIdx.x < 64) F.MISC[threadIdx.x] = 0u;
    Half H; H.hid = F.wave >> 2; H.lds = F.lds + H.hid * HALF_LDS; H.cnt = (LAS unsigned*)(F.lds + MISC_OFF) + 16 + 16 * H.hid; H.tgt = 0u;
    __syncthreads();
    const int lo = args.ph_lo, hi = args.ph_hi;
    const bool one = (hi - lo) > 1;
    XcdBarrier bar; bar.bar = (unsigned*)(ws + WS_CTL) + CW_BAR; bar.x = 0; bar.st = nullptr;
    if (one) bar = xcd_barrier_post((unsigned*)(ws + WS_CTL) + CW_BAR, F.MISC + 8, threadIdx.x == 0);
#ifndef PMASK
#define PMASK 0xFFFF
#endif
#define PM(k) (((PMASK) >> (k)) & 1)
#ifndef DUPMASK
#define DUPMASK 0
#endif
#define REP(k) _Pragma("unroll 1") for (int rep_ = 0; rep_ < 1 + (((DUPMASK) >> (k)) & 1); ++rep_)
#define IN(k) (lo <= (k) && (k) < hi)
#define SEAM(k) do { if (IN(k) && IN((k) + 1)) xcd_barrier(bar, F.wave == 0 && fresh_lane() == 0); } while (0)
    if (PM(0) && IN(0)) REP(0) { p0_prologue(F); } SEAM(0);
#if ADA_DIRECT
    if (PM(1) && IN(1)) REP(1) adaln_direct(F);
#else
    if (PM(1) && IN(1)) REP(1) { pg8::Gemm g{((bf16_t*)(F.ws + fwo((unsigned)(WS_CACT >> 8)))), ((bf16_t*)(F.ws + fwo((unsigned)(WS_WADA >> 8)))), 256, MODLD, D, D}; pg8::StaticOrder S; S.init(256, MODLD, F.G, (int)blockIdx.x, D / 64); EpiMod E{((float*)(F.ws + fwo((unsigned)(WS_MOD >> 8)))), INP(I_BADA)};
        pg8::gemm_phase<EpiMod, pg8::StaticOrder, true, true>(F.lds, g, S, E, F.wave); }
#endif
    SEAM(1);
    constexpr int fusedn = 0;
#pragma unroll 1
    for (int l = 0; l < DEPTH; ++l) {
        const int p0 = 2 + l * PH_PER_LAYER; const int mo = l * 6 * D;
        if (l == 0 || !fusedn || DBG_KEEPNORM) { if (PM(2) && IN(p0 + 0)) REP(2) norm_phase(F, INP(I_N1G) + l * D, mo + 0 * D, mo + 1 * D, l > 0, l == 0 ? INP(I_XP) : nullptr, l == 0 ? INP(I_XS) : nullptr); SEAM(p0 + 0); }
        if (PM(3) && IN(p0 + 1)) REP(3) { pg8::Gemm g{((bf16_t*)(F.ws + fwo((unsigned)(WS_HN >> 8)))), ((bf16_t*)(F.ws + fwo((unsigned)(WS_WIN >> 8)))) + (size_t)l * ZLD * D, M, ZLD, D, D}; pg8::StaticOrder S; S.init(M, ZLD, F.G, (int)blockIdx.x, D / 64, 1, 0, WGM_G1); EpiZ E{((bf16_t*)(F.ws + fwo((unsigned)(WS_Z >> 8)))), ZLD};
            pg8::gemm_phase<EpiZ, pg8::StaticOrder, true, true>(F.lds, g, S, E, F.wave); steal_transposes(F, qcap(l, 28, I_IN + I_OUT)); } SEAM(p0 + 1);
        if (PM(4) && IN(p0 + 2)) REP(4) phase_ma(F, H, l); SEAM(p0 + 2);
        if (PM(5) && IN(p0 + 3)) REP(5) phase_mb(F, l); SEAM(p0 + 3);
        if (PM(6) && IN(p0 + 4)) REP(6) phase_mc(F, H, l); SEAM(p0 + 4);
        if (PM(7) && IN(p0 + 5)) { pg8::Gemm g{((bf16_t*)(F.ws + fwo((unsigned)(WS_MIX >> 8)))), ((bf16_t*)(F.ws + fwo((unsigned)(WS_WOUT >> 8)))) + (size_t)l * D * D, M, D, D, D}; ResOrder S{F.G, (int)blockIdx.x, D / 64, D / SPLIT}; EpiResGate E{((float*)(F.ws + fwo((unsigned)(WS_X >> 8)))), ((float*)(F.ws + fwo((unsigned)(WS_MOD >> 8)))), ((float*)(F.ws + fwo((unsigned)(WS_PART >> 8)))), mo + 2 * D, D / SPLIT, (F.umask & 0x100) ? (float*)(F.ws + fwo((unsigned)(WS_Z >> 8))) : nullptr, l == 0 ? INP(I_XP) : nullptr, l == 0 ? INP(I_XS) : nullptr,
                NormP{INP(I_N2G) + l * D, ((float*)(F.ws + fwo((unsigned)(WS_MOD >> 8)))), mo + 3 * D, mo + 4 * D, ((bf16_t*)(F.ws + fwo((unsigned)(WS_HN >> 8)))), nullptr, ((float*)(F.ws + fwo((unsigned)(WS_PART >> 8)))), (unsigned*)(F.ws + WS_CTL) + CW_PAN + ((l * 2 + 0) * 36) * 64, (unsigned*)(F.ws + WS_CTL) + 2, (LAS unsigned*)(F.lds + HALO_OFF), fusedn}};
            pg8::gemm_phase<EpiResGate, ResOrder, true, true>(F.lds, g, S, E, F.wave); steal_transposes(F, qcap(l, 35, I_IN + I_OUT + I_UP)); } SEAM(p0 + 5);
        if (!fusedn || DBG_KEEPNORM) { if (PM(2) && IN(p0 + 6)) REP(2) norm_phase(F, INP(I_N2G) + l * D, mo + 3 * D, mo + 4 * D, true, nullptr, nullptr); SEAM(p0 + 6); }
        if (PM(9) && IN(p0 + 7)) REP(9) { pg8::Gemm g{((bf16_t*)(F.ws + fwo((unsigned)(WS_HN >> 8)))), ((bf16_t*)(F.ws + fwo((unsigned)(WS_WUP >> 8)))) + (size_t)l * 2 * D_FF * D, M, 2 * D_FF, D, D}; pg8::StaticOrder S; S.init(M, 2 * D_FF, F.G, (int)blockIdx.x, D / 64, 1, 0, WGM_G3);
            EpiConvFfn E{((bf16_t*)(F.ws + fwo((unsigned)(WS_H >> 8)))), ((float*)(F.ws + fwo((unsigned)(WS_RAW >> 8)))), INP(I_FCW) + (size_t)l * 3 * 2 * D_FF, INP(I_FCB) + (size_t)l * 2 * D_FF, ((float*)(F.ws + fwo((unsigned)(WS_RAWS >> 8)))), F.out + O_FCONV_S + (size_t)l * DEC_BATCH * 2 * 2 * D_FF, (LAS float*)(F.lds + HALO_OFF), (F.umask & 0x800) ? 1 : 0};
            pg8::gemm_phase<EpiConvFfn, pg8::StaticOrder, true, true>(F.lds, g, S, E, F.wave); steal_transposes(F, qcap(l, 82, PER_L4)); } SEAM(p0 + 7);
        if (PM(10) && IN(p0 + 8)) REP(10) phase_fx(F, l); SEAM(p0 + 8);
        if (PM(11) && IN(p0 + 9)) { pg8::Gemm g{((bf16_t*)(F.ws + fwo((unsigned)(WS_H >> 8)))), ((bf16_t*)(F.ws + fwo((unsigned)(WS_WDOWN >> 8)))) + (size_t)l * D * D_FF, M, D, D_FF, D_FF}; ResOrder S{F.G, (int)blockIdx.x, D_FF / 64, D_FF / SPLIT}; EpiResGate E{((float*)(F.ws + fwo((unsigned)(WS_X >> 8)))), ((float*)(F.ws + fwo((unsigned)(WS_MOD >> 8)))), ((float*)(F.ws + fwo((unsigned)(WS_PART >> 8)))), mo + 5 * D, D_FF / SPLIT, (F.umask & 0x100) ? (float*)(F.ws + fwo((unsigned)(WS_Z >> 8))) : nullptr, nullptr, nullptr,
                NormP{l + 1 < DEPTH ? INP(I_N1G) + (l + 1) * D : INP(I_FG), ((float*)(F.ws + fwo((unsigned)(WS_MOD >> 8)))), l + 1 < DEPTH ? mo + 6 * D : -1, mo + 7 * D, ((bf16_t*)(F.ws + fwo((unsigned)(WS_HN >> 8)))), F.out + O_YP, ((float*)(F.ws + fwo((unsigned)(WS_PART >> 8)))), (unsigned*)(F.ws + WS_CTL) + CW_PAN + ((l * 2 + 1) * 36) * 64, (unsigned*)(F.ws + WS_CTL) + 2, (LAS unsigned*)(F.lds + HALO_OFF), fusedn}};
            pg8::gemm_phase<EpiResGate, ResOrder, true, true>(F.lds, g, S, E, F.wave); steal_transposes(F, qcap(l, 100, PER_L4 + I_IN)); } SEAM(p0 + 9);
    }
    if (!fusedn || DBG_KEEPNORM) { if (PM(12) && IN(PH_TOTAL - 1)) REP(12) final_norm_phase(F); }
#undef IN
#undef SEAM
}

#ifndef HDUPMASK
#define HDUPMASK 0
#endif
#ifndef HDUPUNITS
#define HDUPUNITS 0xFF
#endif
static void run(void* const* d_in, float* out, void* d_ws, size_t ws_size, hipStream_t stream, int multi) {
    static int grid = 0;
    if (grid == 0) {
        int dev = 0, cus = 0, per_cu = 0;
        if (ws_size < WS_END) { fprintf(stderr, "kernel_launch: workspace too small: %zu < %zu\n", ws_size, (size_t)WS_END); grid = -1; return; }
        if (hipGetDevice(&dev) != hipSuccess || hipDeviceGetAttribute(&cus, hipDeviceAttributeMultiprocessorCount, dev) != hipSuccess) { grid = -1; return; }
        if (hipFuncSetAttribute((const void*)mega, hipFuncAttributeMaxDynamicSharedMemorySize, LDS_BYTES) != hipSuccess) { fprintf(stderr, "kernel_launch: hipFuncSetAttribute failed\n"); grid = -1; return; }
        if (hipOccupancyMaxActiveBlocksPerMultiprocessor(&per_cu, (const void*)mega, NTHR, LDS_BYTES) != hipSuccess || per_cu < 1) { fprintf(stderr, "kernel_launch: occupancy query says %d blocks/CU\n", per_cu); (void)hipGetLastError(); grid = -1; return; }
        grid = cus;
    }
    if (grid < 0) return;
    (void)hipMemsetAsync((char*)d_ws + WS_CTL, 0, CTL_ZERO_BYTES, stream);
    Args a{}; for (int i = 0; i < N_INPUTS; ++i) a.in[i] = (const float*)d_in[i];
    a.out = out; a.ws = (unsigned char*)d_ws; a.umask = 0xFF;
    if (!multi) { a.ph_lo = 0; a.ph_hi = PH_TOTAL; hipLaunchKernelGGL(mega, dim3(grid), dim3(NTHR), LDS_BYTES, stream, a); }
    else for (int p = 0; p < PH_TOTAL; ++p) { a.ph_lo = p; a.ph_hi = p + 1; hipLaunchKernelGGL(mega, dim3(grid), dim3(NTHR), LDS_BYTES, stream, a);
        static const int tmap[10] = {2, 3, 4, 5, 6, 7, 2, 9, 10, 11}; const int ty = p == 0 ? 0 : (p == 1 ? 1 : (p == PH_TOTAL - 1 ? 12 : tmap[(p - 2) % 10]));
        if ((HDUPMASK >> ty) & 1) { a.umask = HDUPUNITS; hipLaunchKernelGGL(mega, dim3(grid), dim3(NTHR), LDS_BYTES, stream, a); a.umask = 0xFF; hipLaunchKernelGGL(mega, dim3(grid), dim3(NTHR), LDS_BYTES, stream, a); } }
}
}
#ifndef FK_MULTI
#define FK_MULTI 0
#endif
extern "C" void kernel_launch(void* const* d_in, const int* in_sizes, int n_in, void* d_out, int out_size, void* d_ws, size_t ws_size, hipStream_t stream) {
    if (n_in != cfg::N_INPUTS || (size_t)out_size != cfg::O_END) { fprintf(stderr, "kernel_launch: unexpected n_in %d / out_size %d\n", n_in, out_size); return; }
    fk::run(d_in, (float*)d_out, d_ws, ws_size, stream, FK_MULTI);
}
```
